# Optimizing an MI355X kernel written in HIP

```python
import jax, jax.numpy as jnp
from jax import lax
import numpy as np

D_MODEL = 1024
BATCH = 4
SEQ = 4096
DEPTH = 1
DEC_BATCH = 128
DEC_SEQ = 1
PAST_LEN = 8192
PAGE_SIZE = 128

N_HEADS = 16
HEAD_DIM = 64
N_KV_HEADS = 4
GROUP = N_HEADS // N_KV_HEADS
ATTN_WIDTH = N_HEADS * HEAD_DIM
KV_WIDTH = N_KV_HEADS * HEAD_DIM
WINDOW = 128
ATTN_BLOCK = WINDOW
ATTN_SCALE = HEAD_DIM ** -0.5
NEG_BIG = -1e30
SGU_CHUNK = 128
SGU_WIDTH = D_MODEL
SGU_GROUPS = 8
SGU_GROUP_DIM = SGU_WIDTH // SGU_GROUPS
D_FF = 4 * D_MODEL
EPS = 1e-6
IN_SIZES = (SGU_WIDTH, SGU_WIDTH, ATTN_WIDTH, KV_WIDTH, KV_WIDTH, D_MODEL, D_MODEL)
IN_WIDTH = sum(IN_SIZES)
IN_OFFSETS = tuple(int(o) for o in np.cumsum(IN_SIZES)[:-1])

kernel_name = "hybrid_gated_sgu_swa_decoder_step"


def rmsnorm(x, g):
    xf = x.astype(jnp.float32)
    y = xf * lax.rsqrt(jnp.mean(xf * xf, axis=-1, keepdims=True) + EPS)
    return (y * g.astype(jnp.float32)).astype(x.dtype)


def alibi_slopes():
    h = jnp.arange(1, N_HEADS + 1, dtype=jnp.float32)
    return jnp.exp2(-8.0 * h / N_HEADS)


def in_proj(x, ln1_g, w_in):
    xn = rmsnorm(x, ln1_g)
    h = xn @ w_in
    u, v, q, k, va, ga, gb = jnp.split(h, IN_OFFSETS, axis=-1)
    u = jax.nn.gelu(u)
    v = jax.nn.gelu(v)
    lead = x.shape[:-1]
    q = q.reshape(lead + (N_KV_HEADS, GROUP, HEAD_DIM))
    k = k.reshape(lead + (N_KV_HEADS, HEAD_DIM))
    va = va.reshape(lead + (N_KV_HEADS, HEAD_DIM))
    return u, v, q, k, va, ga, gb


def sink_attend(q, k, v, dist, valid, sinks, slopes):
    s = jnp.einsum('...qhgd,...shd->...hgqs', q, k).astype(jnp.float32) * ATTN_SCALE
    s = s - slopes.reshape(N_KV_HEADS, GROUP, 1, 1) * dist.astype(jnp.float32)
    s = jnp.where(valid, s, NEG_BIG)
    sink = jnp.broadcast_to(sinks.astype(jnp.float32).reshape(N_KV_HEADS, GROUP, 1, 1), s.shape[:-1] + (1,))
    p = jax.nn.softmax(jnp.concatenate([s, sink], axis=-1), axis=-1)[..., :-1]
    return jnp.einsum('...hgqs,...shd->...qhgd', p.astype(v.dtype), v)


def swa_prompt(q, k, v, sinks, slopes):
    B, T = q.shape[0], q.shape[1]
    nb = T // ATTN_BLOCK
    qb = q.reshape(B, nb, ATTN_BLOCK, N_KV_HEADS, GROUP, HEAD_DIM)
    kb = k.reshape(B, nb, ATTN_BLOCK, N_KV_HEADS, HEAD_DIM)
    vb = v.reshape(B, nb, ATTN_BLOCK, N_KV_HEADS, HEAD_DIM)
    prev = lambda a: jnp.concatenate([jnp.zeros_like(a[:, :1]), a[:, :-1]], axis=1)
    kband = jnp.concatenate([prev(kb), kb], axis=2)
    vband = jnp.concatenate([prev(vb), vb], axis=2)
    qi = jnp.arange(ATTN_BLOCK)[:, None] + ATTN_BLOCK
    kj = jnp.arange(2 * ATTN_BLOCK)[None, :]
    diff = qi - kj
    blk = jnp.arange(nb)[:, None, None]
    key_ok = (blk * ATTN_BLOCK + kj[None] - ATTN_BLOCK) >= 0
    valid = (((diff >= 0) & (diff <= WINDOW))[None] & key_ok)[:, None, None]
    o = sink_attend(qb, kband, vband, diff, valid, sinks, slopes)
    w = min(WINDOW, T)
    return o.reshape(B, T, ATTN_WIDTH), k[:, T - w:], v[:, T - w:]


def swa_sample(q, k, v, cache_k, cache_v, sinks, slopes):
    T = q.shape[1]
    w_buf = cache_k.shape[1]
    kf = jnp.concatenate([cache_k, k], axis=1)
    vf = jnp.concatenate([cache_v, v], axis=1)
    diff = (jnp.arange(T)[:, None] + w_buf) - jnp.arange(w_buf + T)[None, :]
    valid = (diff >= 0) & (diff <= WINDOW)
    o = sink_attend(q, kf, vf, diff, valid, sinks, slopes)
    return o.reshape(q.shape[0], T, ATTN_WIDTH), kf[:, T:], vf[:, T:]


def causal_mix_matrix(sgu_w):
    mask = jnp.tril(jnp.ones((SGU_CHUNK, SGU_CHUNK), dtype=bool))
    return sgu_w * mask.astype(sgu_w.dtype)


def sgu_prompt(u, v, g, sgu_w, sgu_b):
    B, T, _ = v.shape
    nc = T // SGU_CHUNK
    vn = rmsnorm(v, g).reshape(B, nc, SGU_CHUNK, SGU_GROUPS, SGU_GROUP_DIM)
    mixed = jnp.einsum('gts,bcsgd->bctgd', causal_mix_matrix(sgu_w), vn) + sgu_b.T[None, None, :, :, None]
    return u * mixed.reshape(B, T, SGU_WIDTH)


def sgu_sample(u, v, g, sgu_w, sgu_b):
    Bd, T, _ = v.shape
    vn = rmsnorm(v, g)
    vg = vn.reshape(Bd, T, SGU_GROUPS, SGU_GROUP_DIM)
    w = causal_mix_matrix(sgu_w)[:, :T, :T]
    mixed = jnp.einsum('gts,bsgd->btgd', w, vg) + sgu_b[:, :T].T[None, :, :, None]
    return u * mixed.reshape(Bd, T, SGU_WIDTH), vn


def merge_and_ffn(x, a, b, ga, gb, w_oa, w_ob, w_out, ln2_g, w_up, w_down):
    h = jax.nn.sigmoid(ga) * (a @ w_oa) + jax.nn.sigmoid(gb) * (b @ w_ob)
    x = x + h @ w_out
    xn = rmsnorm(x, ln2_g)
    return x + jnp.square(jax.nn.relu(xn @ w_up)) @ w_down


def setup_inputs(seed: int = 0) -> dict:
    key = jax.random.key(seed)
    ks = jax.random.split(key, 20)
    nrm = lambda k, shape, scale: jax.random.normal(k, shape, jnp.float32) * scale
    gain = lambda k, shape: 1.0 + nrm(k, shape, 0.02)
    cache_shape = (DEPTH, DEC_BATCH, WINDOW, N_KV_HEADS, HEAD_DIM)
    return {
        "x_prompt": nrm(ks[0], (BATCH, SEQ, D_MODEL), 1.0),
        "x_sample": nrm(ks[1], (DEC_BATCH, DEC_SEQ, D_MODEL), 1.0),
        "cache_k_win": nrm(ks[2], cache_shape, 1.0),
        "cache_v_win": nrm(ks[3], cache_shape, 1.0),
        "ln1_g": gain(ks[4], (DEPTH, D_MODEL)),
        "w_in": nrm(ks[5], (DEPTH, D_MODEL, IN_WIDTH), D_MODEL ** -0.5),
        "sgu_norm_g": gain(ks[6], (DEPTH, SGU_WIDTH)),
        "sgu_w": nrm(ks[7], (DEPTH, SGU_GROUPS, SGU_CHUNK, SGU_CHUNK), 0.5 * SGU_CHUNK ** -0.5),
        "sgu_b": 1.0 + nrm(ks[8], (DEPTH, SGU_GROUPS, SGU_CHUNK), 0.1),
        "attn_sinks": nrm(ks[9], (DEPTH, N_HEADS), 1.0),
        "w_oa": nrm(ks[10], (DEPTH, SGU_WIDTH, D_MODEL), SGU_WIDTH ** -0.5),
        "w_ob": nrm(ks[11], (DEPTH, ATTN_WIDTH, D_MODEL), ATTN_WIDTH ** -0.5),
        "w_out": nrm(ks[12], (DEPTH, D_MODEL, D_MODEL), D_MODEL ** -0.5),
        "ln2_g": gain(ks[13], (DEPTH, D_MODEL)),
        "w_up": nrm(ks[14], (DEPTH, D_MODEL, D_FF), D_MODEL ** -0.5),
        "w_down": nrm(ks[15], (DEPTH, D_FF, D_MODEL), D_FF ** -0.5),
        "lnf_g": gain(ks[16], (D_MODEL,)),
    }


def reference(x_prompt, x_sample, cache_k_win, cache_v_win, ln1_g, w_in, sgu_norm_g, sgu_w, sgu_b,
              attn_sinks, w_oa, w_ob, w_out, ln2_g, w_up, w_down, lnf_g):
    slopes = alibi_slopes().astype(jnp.float32)
    xp, xs = x_prompt, x_sample
    kp_l, vp_l, ks_l, vs_l, sv_l = [], [], [], [], []
    for l in range(DEPTH):
        u, v, q, k, va, ga, gb = in_proj(xp, ln1_g[l], w_in[l])
        a = sgu_prompt(u, v, sgu_norm_g[l], sgu_w[l], sgu_b[l])
        b, kw, vw = swa_prompt(q, k, va, attn_sinks[l], slopes)
        xp = merge_and_ffn(xp, a, b, ga, gb, w_oa[l], w_ob[l], w_out[l], ln2_g[l], w_up[l], w_down[l])
        kp_l.append(kw)
        vp_l.append(vw)
        u, v, q, k, va, ga, gb = in_proj(xs, ln1_g[l], w_in[l])
        a, vrows = sgu_sample(u, v, sgu_norm_g[l], sgu_w[l], sgu_b[l])
        b, kw, vw = swa_sample(q, k, va, cache_k_win[l], cache_v_win[l], attn_sinks[l], slopes)
        xs = merge_and_ffn(xs, a, b, ga, gb, w_oa[l], w_ob[l], w_out[l], ln2_g[l], w_up[l], w_down[l])
        ks_l.append(kw)
        vs_l.append(vw)
        sv_l.append(vrows)
    y_prompt = rmsnorm(xp, lnf_g)
    y_sample = rmsnorm(xs, lnf_g)
    new_k_win_prompt = jnp.stack(kp_l)
    new_v_win_prompt = jnp.stack(vp_l)
    new_k_win_sample = jnp.stack(ks_l)
    new_v_win_sample = jnp.stack(vs_l)
    new_sgu_v_sample = jnp.stack(sv_l)
    return (y_prompt, y_sample, new_k_win_prompt, new_v_win_prompt, new_k_win_sample, new_v_win_sample, new_sgu_v_sample)
```

```cpp
#include <hip/hip_runtime.h>
#include <hip/hip_cooperative_groups.h>
#include <cstdio>
#include <cstdint>
namespace cg = cooperative_groups;

#define LAS __attribute__((address_space(3)))
#define PG8_LAS __attribute__((address_space(3)))
typedef unsigned short bf16_t;
typedef short bf16x8 __attribute__((ext_vector_type(8)));
typedef short s16x4 __attribute__((ext_vector_type(4)));
typedef float f32x4 __attribute__((ext_vector_type(4)));
typedef float f32x2 __attribute__((ext_vector_type(2)));
typedef unsigned u32x4 __attribute__((ext_vector_type(4)));
typedef unsigned u32x2 __attribute__((ext_vector_type(2)));

constexpr int D = 1024, SEQ = 4096, NBATCH = 4, MP = NBATCH * SEQ, NS = 128, INW = 5632, FF = 4096;
constexpr int C_U = 0, C_V = 1024, C_Q = 2048, C_K = 3072, C_VA = 3328, C_GA = 3584, C_GB = 4608;
constexpr float EPS = 1e-6f;
constexpr float LOG2E = 1.4426950408889634f;
constexpr size_t O_YP = 0, O_YS = (size_t)MP * D, O_KWP = O_YS + (size_t)NS * D, O_VWP = O_KWP + 131072, O_KWS = O_VWP + 131072,
                 O_VWS = O_KWS + 4194304, O_SGV = O_VWS + 4194304, O_END = O_SGV + 131072;
constexpr size_t KiB = 1024, MiB = 1024 * 1024;
constexpr size_t WS_VSS = 0, WS_X1SS = 1 * MiB;
constexpr size_t WS_XNS = 2 * MiB, WS_HS = WS_XNS + 256 * KiB, WS_ABS = 5 * MiB, WS_HGS = WS_ABS + 512 * KiB, WS_X1S = WS_HGS + 256 * KiB,
                 WS_X1BS = WS_X1S + 512 * KiB, WS_FS = WS_X1BS + 256 * KiB, WS_DS = WS_FS + 1 * MiB, WS_WTRIL = WS_DS + 2 * MiB;
constexpr size_t WS_WIN = 10 * MiB, WS_WOAB = 21 * MiB, WS_WOUT = 25 * MiB, WS_WUP = 27 * MiB, WS_WDOWN = 35 * MiB;
constexpr size_t WS_H = 44 * MiB, WS_X1B = WS_H, WS_F = WS_H + 32 * MiB, WS_XN = 220 * MiB, WS_T1 = WS_XN, WS_END = 252 * MiB;
static_assert(WS_HS + (size_t)NS * INW * 4 <= WS_ABS && WS_WTRIL + 256 * KiB <= WS_WIN && WS_WIN + (size_t)INW * D * 2 <= WS_WOAB, "ws map");
static_assert(WS_H + (size_t)MP * INW * 2 <= WS_XN && WS_F + (size_t)MP * FF * 2 <= WS_XN, "ws map 2");
constexpr int LDS_BYTES = 147456;

__device__ __forceinline__ unsigned cvt_pk_bf16(float lo, float hi) { unsigned r; asm volatile("v_cvt_pk_bf16_f32 %0, %1, %2" : "=v"(r) : "v"(lo), "v"(hi)); return r; }
__device__ __forceinline__ float bflo(unsigned w) { return __uint_as_float(w << 16); }
__device__ __forceinline__ float bfhi(unsigned w) { return __uint_as_float(w & 0xffff0000u); }
__device__ __forceinline__ float bf1(bf16_t h) { return __uint_as_float(((unsigned)h) << 16); }
__device__ __forceinline__ float gelu_t(float x) {
    const float u = x * (1.0f + 0.044715f * x * x);
    const float e = __builtin_amdgcn_exp2f(-2.302208198f * u);
    return x * __builtin_amdgcn_rcpf(1.0f + e);
}
__device__ __forceinline__ float sigmoid_f(float x) { return __builtin_amdgcn_rcpf(1.0f + __builtin_amdgcn_exp2f(-LOG2E * x)); }
__device__ __forceinline__ int opaque_tid() { int t = threadIdx.x; asm volatile("" : "+v"(t)); return t; }
__device__ __forceinline__ float wave_sum(float v) {
#pragma unroll
    for (int o = 1; o < 64; o <<= 1) v += __shfl_xor(v, o);
    return v;
}
__device__ __forceinline__ s16x4 tr_read(const LAS bf16_t* p) {
    typedef short v4i16_t __attribute__((ext_vector_type(4)));
    return __builtin_bit_cast(s16x4, __builtin_amdgcn_ds_read_tr16_b64_v4i16((LAS v4i16_t*)p));
}

namespace pg8 {
constexpr int BM = 256, BK = 64, HALF = 128, HTB = HALF * BK * 2, STAGE_BYTES = 8 * HTB, NXCD = 8, WGM = 8;
__host__ __device__ __forceinline__ int lds_byte(int r, int c) { const int st = (r >> 4) * 2 + (c >> 5), rr = r & 15, cc = c & 31, ob = rr * 64 + cc * 2; return st * 1024 + (ob ^ (((ob >> 9) & 1) << 5)); }
__host__ __device__ __forceinline__ void stage_rc(int b, int& R, int& C) { const int st = b / 1024, sb = b % 1024, swz = sb ^ (((sb >> 9) & 1) << 5); R = (st >> 1) * 16 + swz / 64; C = (st & 1) * 32 + (swz % 64) / 2; }
__host__ __device__ __forceinline__ int perm32(int rho) { const int n = rho >> 4, i = rho & 15; return 8 * (i >> 2) + 4 * n + (i & 3); }

struct Unit { int pm, pn, sub; };
struct Gemm { const bf16_t* A; const bf16_t* Bt; int lda, K; size_t a_sub_off; int b_sub_tiles; };

struct StaticOrder {
    int nM, nN, nwg, G, c, nsub;
    __host__ __device__ void init(int M, int N, int G_, int c_, int nsub_) { nM = M / BM; nN = N / BM; nwg = nM * nN; G = G_; c = c_; nsub = nsub_; }
    __host__ __device__ bool next(int i, Unit& u) const {
        const int j = i / nsub; u.sub = i - j * nsub;
        const long L = (long)j * G + c; if (L >= nwg) return false;
        int wgid = (int)L; { const int q = nwg / NXCD, r = nwg % NXCD, xcd = wgid % NXCD, off = wgid / NXCD; wgid = (xcd < r ? xcd * (q + 1) : r * (q + 1) + (xcd - r) * q) + off; }
        const int nig = WGM * nN, gid = wgid / nig, fm = gid * WGM, gsz = (nM - fm) < WGM ? (nM - fm) : WGM;
        u.pm = fm + ((wgid % nig) % gsz); u.pn = (wgid % nig) / gsz; return true;
    }
    __device__ __forceinline__ void a_ready(const Unit&) const {}
    __device__ __forceinline__ void done(const Unit&) const {}
};

__device__ __forceinline__ u32x4 pack8(const f32x4 v0, const f32x4 v1) { u32x4 w; w.x = cvt_pk_bf16(v0[0], v0[1]); w.y = cvt_pk_bf16(v0[2], v0[3]); w.z = cvt_pk_bf16(v1[0], v1[1]); w.w = cvt_pk_bf16(v1[2], v1[3]); return w; }

struct EpiIn {
    static constexpr bool PERM = true, AFTER_DRAIN = false;
    bf16_t* H; float* vss;
    __device__ __forceinline__ void operator()(const f32x4 (&acc)[2][2][4][2], const Unit& u, int wr, int wc, int fr, int fq) const {
        const int pn = u.pn; const int mode = pn < 8 ? 1 : (pn < 14 ? 0 : 2); const bool isv = (pn >= 4 && pn < 8);
        const int row0 = u.pm * BM + wr * 64 + fr, col0 = pn * BM + wc * 32 + 8 * fq;
#pragma unroll
        for (int ai = 0; ai < 2; ++ai)
#pragma unroll
            for (int m = 0; m < 4; ++m) { const int row = row0 + ai * HALF + m * 16; bf16_t* rowp = H + (size_t)row * INW + col0; float ss = 0.f;
#pragma unroll
                for (int bj = 0; bj < 2; ++bj) { f32x4 v0 = acc[ai][bj][m][0], v1 = acc[ai][bj][m][1];
                    if (mode == 1) {
#pragma unroll
                        for (int e = 0; e < 4; ++e) { v0[e] = gelu_t(v0[e]); v1[e] = gelu_t(v1[e]); }
                        if (isv) {
#pragma unroll
                            for (int e = 0; e < 4; ++e) ss += v0[e] * v0[e] + v1[e] * v1[e]; }
                    } else if (mode == 2) {
#pragma unroll
                        for (int e = 0; e < 4; ++e) { v0[e] = sigmoid_f(v0[e]); v1[e] = sigmoid_f(v1[e]); }
                    }
                    *(u32x4*)(rowp + bj * HALF) = pack8(v0, v1); }
                if (isv) { ss += __shfl_xor(ss, 16); ss += __shfl_xor(ss, 32); if (fq == 0) vss[(size_t)row * 16 + (pn - 4) * 4 + wc] = ss; }
            }
    }
};
struct EpiOab {
    static constexpr bool PERM = true, AFTER_DRAIN = false;
    const bf16_t* H; bf16_t* T1;
    __device__ __forceinline__ void operator()(const f32x4 (&acc)[2][2][4][2], const Unit& u, int wr, int wc, int fr, int fq) const {
        const int row0 = u.pm * BM + wr * 64 + fr, col0 = u.pn * BM + wc * 32 + 8 * fq; const int gcol = C_GA + u.sub * 1024 + col0; const bool second = u.sub != 0;
#pragma unroll
        for (int ai = 0; ai < 2; ++ai)
#pragma unroll
            for (int m = 0; m < 4; ++m) { const int row = row0 + ai * HALF + m * 16;
#pragma unroll
                for (int bj = 0; bj < 2; ++bj) {
                    const u32x4 gw = *(const u32x4*)(H + (size_t)row * INW + gcol + bj * HALF);
                    f32x4 v0 = acc[ai][bj][m][0], v1 = acc[ai][bj][m][1];
                    v0[0] *= bflo(gw.x); v0[1] *= bfhi(gw.x); v0[2] *= bflo(gw.y); v0[3] *= bfhi(gw.y);
                    v1[0] *= bflo(gw.z); v1[1] *= bfhi(gw.z); v1[2] *= bflo(gw.w); v1[3] *= bfhi(gw.w);
                    bf16_t* tp = T1 + (size_t)row * D + col0 + bj * HALF;
                    if (second) { const u32x4 tw = *(const u32x4*)tp;
                        v0[0] += bflo(tw.x); v0[1] += bfhi(tw.x); v0[2] += bflo(tw.y); v0[3] += bfhi(tw.y);
                        v1[0] += bflo(tw.z); v1[1] += bfhi(tw.z); v1[2] += bflo(tw.w); v1[3] += bfhi(tw.w); }
                    *(u32x4*)tp = pack8(v0, v1); }
            }
    }
};
struct EpiOut {
    static constexpr bool PERM = true, AFTER_DRAIN = false;
    const float* x; float* y; bf16_t* X1B; float* x1ss;
    __device__ __forceinline__ void operator()(const f32x4 (&acc)[2][2][4][2], const Unit& u, int wr, int wc, int fr, int fq) const {
        const int row0 = u.pm * BM + wr * 64 + fr, col0 = u.pn * BM + wc * 32 + 8 * fq;
#pragma unroll
        for (int ai = 0; ai < 2; ++ai)
#pragma unroll
            for (int m = 0; m < 4; ++m) { const int row = row0 + ai * HALF + m * 16; float ss = 0.f;
#pragma unroll
                for (int bj = 0; bj < 2; ++bj) { const size_t off = (size_t)row * D + col0 + bj * HALF;
                    const f32x4 v0 = acc[ai][bj][m][0] + *(const f32x4*)(x + off), v1 = acc[ai][bj][m][1] + *(const f32x4*)(x + off + 4);
                    *(f32x4*)(y + off) = v0; *(f32x4*)(y + off + 4) = v1; *(u32x4*)(X1B + off) = pack8(v0, v1);
#pragma unroll
                    for (int e = 0; e < 4; ++e) ss += v0[e] * v0[e] + v1[e] * v1[e]; }
                ss += __shfl_xor(ss, 16); ss += __shfl_xor(ss, 32); if (fq == 0) x1ss[(size_t)row * 16 + u.pn * 4 + wc] = ss;
            }
    }
};
struct EpiUp {
    static constexpr bool PERM = true, AFTER_DRAIN = false;
    bf16_t* F;
    __device__ __forceinline__ void operator()(const f32x4 (&acc)[2][2][4][2], const Unit& u, int wr, int wc, int fr, int fq) const {
        const int row0 = u.pm * BM + wr * 64 + fr, col0 = u.pn * BM + wc * 32 + 8 * fq;
#pragma unroll
        for (int ai = 0; ai < 2; ++ai)
#pragma unroll
            for (int m = 0; m < 4; ++m) { const int row = row0 + ai * HALF + m * 16;
#pragma unroll
                for (int bj = 0; bj < 2; ++bj) { f32x4 v0 = acc[ai][bj][m][0], v1 = acc[ai][bj][m][1];
#pragma unroll
                    for (int e = 0; e < 4; ++e) { const float a = fmaxf(v0[e], 0.f), b = fmaxf(v1[e], 0.f); v0[e] = a * a; v1[e] = b * b; }
                    *(u32x4*)(F + (size_t)row * FF + col0 + bj * HALF) = pack8(v0, v1); }
            }
    }
};
struct EpiDown {
    static constexpr bool PERM = true, AFTER_DRAIN = false;
    float* y; const float* x1ss;
    __device__ __forceinline__ void operator()(const f32x4 (&acc)[2][2][4][2], const Unit& u, int wr, int wc, int fr, int fq) const {
        const int row0 = u.pm * BM + wr * 64 + fr, col0 = u.pn * BM + wc * 32 + 8 * fq;
#pragma unroll
        for (int ai = 0; ai < 2; ++ai)
#pragma unroll
            for (int m = 0; m < 4; ++m) { const int row = row0 + ai * HALF + m * 16;
                const f32x4* sp = (const f32x4*)(x1ss + (size_t)row * 16); const f32x4 s4 = (sp[0] + sp[1]) + (sp[2] + sp[3]);
                const float r2 = 1.0f / (((s4[0] + s4[1]) + (s4[2] + s4[3])) * (1.0f / D) + EPS);
#pragma unroll
                for (int bj = 0; bj < 2; ++bj) { const size_t off = (size_t)row * D + col0 + bj * HALF;
                    const f32x4 v0 = *(const f32x4*)(y + off) + acc[ai][bj][m][0] * r2, v1 = *(const f32x4*)(y + off + 4) + acc[ai][bj][m][1] * r2;
                    *(f32x4*)(y + off) = v0; *(f32x4*)(y + off + 4) = v1; }
            }
    }
};

template <class Epi, class Sched, bool ALIGN_EPI = false, bool SP2 = false>
__device__ __forceinline__ void gemm_phase(PG8_LAS unsigned char* lds, const Gemm g, const Sched& S, const Epi& E) {
    const int tid = opaque_tid(), wid = __builtin_amdgcn_readfirstlane(tid >> 6), lane = tid & 63, wr = wid >> 2, wc = wid & 3, fr = lane & 15, fq = lane >> 4;
    const int K = g.K, nt = K / BK;
    unsigned voffA[2], voffB[2];
#pragma unroll
    for (int i = 0; i < 2; ++i) { int R, C; stage_rc(tid * 16 + i * 8192, R, C); const int Rb = Epi::PERM ? ((R & ~31) + perm32(R & 31)) : R;
        voffA[i] = (unsigned)(R * g.lda + C) * 2u; voffB[i] = (unsigned)(Rb * K + C) * 2u; }
    const size_t kstep = (size_t)(BK * 2);
    const size_t hstepA = (size_t)HALF * g.lda * 2, hstepB = (size_t)HALF * K * 2;
    const size_t tstepA = 2 * hstepA, tstepB = 2 * hstepB;
    const unsigned ldsw = (unsigned)wid * 1024u;
    const int aoff = lds_byte(wr * 64 + fr, fq * 8), boff = lds_byte(wc * 32 + fr, fq * 8);
#define PG8_SA(b, h) (((b) * 2 + (h)) * HTB)
#define PG8_SB(b, h) ((4 + (b) * 2 + (h)) * HTB)
#define PG8_STAGE(bufoff, gbase, voff) do { _Pragma("unroll") for (int _i = 0; _i < 2; ++_i) \
        __builtin_amdgcn_global_load_lds((const unsigned*)((const char*)(gbase) + (voff)[_i]), (PG8_LAS unsigned*)(lds + (bufoff) + ldsw + _i * 8192), 16, 0, 0); } while (0)
#define PG8_LDA(dst, b, h) do { _Pragma("unroll") for (int m = 0; m < 4; ++m) _Pragma("unroll") for (int k = 0; k < 2; ++k) dst[m][k] = *(const PG8_LAS bf16x8*)(lds + PG8_SA(b, h) + aoff + m * 2048 + k * 1024); } while (0)
#define PG8_LDB(dst, b, h) do { _Pragma("unroll") for (int n = 0; n < 2; ++n) _Pragma("unroll") for (int k = 0; k < 2; ++k) dst[n][k] = *(const PG8_LAS bf16x8*)(lds + PG8_SB(b, h) + boff + n * 2048 + k * 1024); } while (0)
#define PG8_MMA(ai, bj, At, Bt) do { __builtin_amdgcn_s_setprio(1); _Pragma("unroll") for (int m = 0; m < 4; ++m) _Pragma("unroll") for (int n = 0; n < 2; ++n) _Pragma("unroll") for (int k = 0; k < 2; ++k) \
        acc[ai][bj][m][n] = __builtin_amdgcn_mfma_f32_16x16x32_bf16(Bt[n][k], At[m][k], acc[ai][bj][m][n], 0, 0, 0); __builtin_amdgcn_s_setprio(0); } while (0)
#define PG8_WAIT_V(n) asm volatile("s_waitcnt vmcnt(" #n ")" ::: "memory")
#define PG8_WAIT_L(n) asm volatile("s_waitcnt lgkmcnt(" #n ")" ::: "memory")
#define PG8_BAR __builtin_amdgcn_s_barrier()
#define PG8_SCHED __builtin_amdgcn_sched_barrier(0)
    Unit cur, nxt; int ui = 0;
    if (!S.next(0, cur)) return;
    f32x4 acc[2][2][4][2];
#pragma unroll
    for (int a = 0; a < 2; ++a)
#pragma unroll
        for (int b = 0; b < 2; ++b)
#pragma unroll
            for (int m = 0; m < 4; ++m)
#pragma unroll
                for (int n = 0; n < 2; ++n) acc[a][b][m][n] = (f32x4){0.f, 0.f, 0.f, 0.f};
    bf16x8 At[4][2], B0[2][2], B1[2][2];
    const char* cA = (const char*)g.A + (size_t)cur.pm * tstepA + (size_t)cur.sub * g.a_sub_off; const char* cB = (const char*)g.Bt + (size_t)(cur.pn + cur.sub * g.b_sub_tiles) * tstepB;
    S.a_ready(cur);
    if constexpr (SP2) {
        PG8_STAGE(PG8_SB(0, 0), cB, voffB); PG8_STAGE(PG8_SB(0, 1), cB + hstepB, voffB); PG8_STAGE(PG8_SA(0, 0), cA, voffA); PG8_STAGE(PG8_SA(0, 1), cA + hstepA, voffA);
        if (wr == 1) PG8_BAR;
        PG8_WAIT_V(2); PG8_BAR;
        PG8_STAGE(PG8_SB(1, 0), cB + kstep, voffB); PG8_STAGE(PG8_SA(1, 0), cA + kstep, voffA); PG8_STAGE(PG8_SB(1, 1), cB + hstepB + kstep, voffB);
        PG8_WAIT_V(6); PG8_BAR;
    } else {
        PG8_STAGE(PG8_SB(0, 0), cB, voffB); PG8_STAGE(PG8_SA(0, 0), cA, voffA); PG8_STAGE(PG8_SB(0, 1), cB + hstepB, voffB); PG8_STAGE(PG8_SA(0, 1), cA + hstepA, voffA);
        if (wr == 1) PG8_BAR;
        PG8_WAIT_V(4); PG8_BAR;
        PG8_STAGE(PG8_SB(1, 0), cB + kstep, voffB); PG8_STAGE(PG8_SA(1, 0), cA + kstep, voffA); PG8_STAGE(PG8_SB(1, 1), cB + hstepB + kstep, voffB);
        PG8_WAIT_V(6); PG8_BAR;
    }
    for (;;) {
        const bool has_next = S.next(ui + 1, nxt);
        const char* nA = has_next ? (const char*)g.A + (size_t)nxt.pm * tstepA + (size_t)nxt.sub * g.a_sub_off : cA; const char* nB = has_next ? (const char*)g.Bt + (size_t)(nxt.pn + nxt.sub * g.b_sub_tiles) * tstepB : cB;
        for (int t = 0; t < nt; t += 2) {
            const bool last = (t == nt - 2);
            const char* a1 = cA + (size_t)(t + 1) * kstep;
            const char* a2 = last ? nA : cA + (size_t)(t + 2) * kstep; const char* b2 = last ? nB : cB + (size_t)(t + 2) * kstep;
            const char* a3 = a2 + kstep; const char* b3 = b2 + kstep;
            if (last && has_next) S.a_ready(nxt);
            if constexpr (SP2) {
            PG8_LDB(B0, 0, 0); PG8_LDB(B1, 0, 1); PG8_SCHED; PG8_LDA(At, 0, 0); PG8_STAGE(PG8_SA(1, 1), a1 + hstepA, voffA);
            PG8_WAIT_V(8); PG8_WAIT_L(0); PG8_BAR; PG8_MMA(0, 0, At, B0); PG8_MMA(0, 1, At, B1); PG8_BAR; PG8_SCHED;
            PG8_LDA(At, 0, 1); PG8_STAGE(PG8_SB(0, 0), b2, voffB); PG8_STAGE(PG8_SB(0, 1), b2 + hstepB, voffB); PG8_STAGE(PG8_SA(0, 0), a2, voffA);
            PG8_WAIT_V(8); PG8_WAIT_L(0); PG8_BAR; PG8_MMA(1, 0, At, B0); PG8_MMA(1, 1, At, B1); PG8_BAR; PG8_SCHED;
            PG8_LDB(B0, 1, 0); PG8_LDB(B1, 1, 1); PG8_SCHED; PG8_LDA(At, 1, 0); PG8_STAGE(PG8_SA(0, 1), a2 + hstepA, voffA);
            PG8_WAIT_V(8); PG8_WAIT_L(0); PG8_BAR; PG8_MMA(0, 0, At, B0); PG8_MMA(0, 1, At, B1); PG8_BAR; PG8_SCHED;
            PG8_LDA(At, 1, 1); PG8_STAGE(PG8_SB(1, 0), b3, voffB); PG8_STAGE(PG8_SB(1, 1), b3 + hstepB, voffB); PG8_STAGE(PG8_SA(1, 0), a3, voffA);
            PG8_WAIT_V(8); PG8_WAIT_L(0); PG8_BAR; PG8_MMA(1, 0, At, B0); PG8_MMA(1, 1, At, B1); PG8_BAR; PG8_SCHED;
            } else {
            PG8_LDB(B0, 0, 0); PG8_SCHED; PG8_LDA(At, 0, 0); PG8_STAGE(PG8_SA(1, 1), a1 + hstepA, voffA);
            PG8_WAIT_L(8); PG8_BAR; PG8_WAIT_L(0); PG8_MMA(0, 0, At, B0); PG8_BAR; PG8_SCHED;
            PG8_LDB(B1, 0, 1); PG8_STAGE(PG8_SB(0, 0), b2, voffB);
            PG8_BAR; PG8_WAIT_L(0); PG8_MMA(0, 1, At, B1); PG8_BAR;
            PG8_LDA(At, 0, 1); PG8_STAGE(PG8_SA(0, 0), a2, voffA);
            PG8_BAR; PG8_WAIT_L(0); PG8_MMA(1, 0, At, B0); PG8_BAR; PG8_SCHED;
            PG8_STAGE(PG8_SB(0, 1), b2 + hstepB, voffB);
            PG8_WAIT_V(6); PG8_BAR; PG8_MMA(1, 1, At, B1); PG8_BAR;
            PG8_LDB(B0, 1, 0); PG8_SCHED; PG8_LDA(At, 1, 0); PG8_STAGE(PG8_SA(0, 1), a2 + hstepA, voffA);
            PG8_WAIT_L(8); PG8_BAR; PG8_WAIT_L(0); PG8_MMA(0, 0, At, B0); PG8_BAR; PG8_SCHED;
            PG8_LDB(B1, 1, 1); PG8_STAGE(PG8_SB(1, 0), b3, voffB);
            PG8_BAR; PG8_WAIT_L(0); PG8_MMA(0, 1, At, B1); PG8_BAR;
            PG8_LDA(At, 1, 1); PG8_STAGE(PG8_SA(1, 0), a3, voffA);
            PG8_BAR; PG8_WAIT_L(0); PG8_MMA(1, 0, At, B0); PG8_BAR; PG8_SCHED;
            PG8_STAGE(PG8_SB(1, 1), b3 + hstepB, voffB);
            PG8_WAIT_V(6); PG8_BAR; PG8_MMA(1, 1, At, B1); PG8_BAR;
            }
        }
        if constexpr (ALIGN_EPI) { if (wr == 0) PG8_BAR; }
        if constexpr (!Epi::AFTER_DRAIN) { E(acc, cur, wr, wc, fr, fq); S.done(cur); }
        if (!has_next) break;
#pragma unroll
        for (int a = 0; a < 2; ++a)
#pragma unroll
            for (int b = 0; b < 2; ++b)
#pragma unroll
                for (int m = 0; m < 4; ++m)
#pragma unroll
                    for (int n = 0; n < 2; ++n) acc[a][b][m][n] = (f32x4){0.f, 0.f, 0.f, 0.f};
        cur = nxt; cA = nA; cB = nB; ++ui;
        if constexpr (ALIGN_EPI) { if (wr == 1) PG8_BAR; }
    }
    PG8_WAIT_V(0);
    if constexpr (!ALIGN_EPI) { if (wr == 0) PG8_BAR; }
    PG8_BAR;
    if constexpr (Epi::AFTER_DRAIN) { E.fused(acc, cur, wr, wc, fr, fq, lds, wid, lane); S.done(cur); }
#undef PG8_SA
#undef PG8_SB
#undef PG8_STAGE
#undef PG8_LDA
#undef PG8_LDB
#undef PG8_MMA
#undef PG8_WAIT_V
#undef PG8_WAIT_L
#undef PG8_BAR
#undef PG8_SCHED
}

}

struct Args { const float* in[17]; float* out; unsigned char* ws; };
struct Ctx {
    const float *xp, *xs, *ck, *cv, *g1, *w_in, *gs, *sgu_w, *sgu_b, *sinks, *w_oa, *w_ob, *w_out, *g2, *w_up, *w_down, *gf;
    float* out; unsigned char* ws;
    int G, bid;
};
#define MFMA16(a, b, c) __builtin_amdgcn_mfma_f32_16x16x32_bf16((a), (b), (c), 0, 0, 0)

__device__ __forceinline__ void p0_transpose_item(const float* W, int K, int N, bf16_t* WT, int row_off, const float* kscale, LAS float* scr, int item, int lane) {
    const int nblk = N / 32, kb = item / nblk, nb = item % nblk, k0 = 64 * kb, n0 = 32 * nb;
#pragma unroll 8
    for (int i = 0; i < 32; ++i) { const int kk = 2 * i + (lane >> 5); float v = W[(size_t)(k0 + kk) * N + n0 + (lane & 31)]; if (kscale) v *= kscale[k0 + kk]; scr[kk * 33 + (lane & 31)] = v; }
    asm volatile("s_waitcnt lgkmcnt(0)" ::: "memory");
    const int c = lane & 7;
#pragma unroll
    for (int j = 0; j < 4; ++j) { const int n = (lane >> 3) + 8 * j; const LAS float* s = scr + (8 * c) * 33 + n;
        u32x4 o; o.x = cvt_pk_bf16(s[0 * 33], s[1 * 33]); o.y = cvt_pk_bf16(s[2 * 33], s[3 * 33]); o.z = cvt_pk_bf16(s[4 * 33], s[5 * 33]); o.w = cvt_pk_bf16(s[6 * 33], s[7 * 33]);
        *(u32x4*)(WT + (size_t)(row_off + n0 + n) * K + k0 + 8 * c) = o; }
    asm volatile("s_waitcnt lgkmcnt(0)" ::: "memory");
}
__device__ __forceinline__ void rms_row_to_bf16(const float* xrow, const float* g, bf16_t* orow, int lane) {
    const f32x4* xr = (const f32x4*)xrow + lane; const f32x4* gr = (const f32x4*)g + lane;
    f32x4 v[4]; float s = 0.f;
#pragma unroll
    for (int j = 0; j < 4; ++j) { v[j] = xr[64 * j]; s += (v[j].x * v[j].x + v[j].y * v[j].y) + (v[j].z * v[j].z + v[j].w * v[j].w); }
    const float r = 1.0f / sqrtf(wave_sum(s) * (1.0f / D) + EPS);
    u32x2* o8 = (u32x2*)orow + lane;
#pragma unroll
    for (int j = 0; j < 4; ++j) { const f32x4 gg = gr[64 * j]; u32x2 w; w.x = cvt_pk_bf16(v[j].x * r * gg.x, v[j].y * r * gg.y); w.y = cvt_pk_bf16(v[j].z * r * gg.z, v[j].w * r * gg.w); o8[64 * j] = w; }
}
__device__ __forceinline__ void p0_prologue(const Ctx& F, LAS unsigned char* lds) {
    const int tid_ = opaque_tid(), lane_ = tid_ & 63, wave_ = __builtin_amdgcn_readfirstlane(tid_ >> 6);
    LAS float* scr = (LAS float*)(lds + wave_ * 16384);
    const int gw = F.bid * 8 + wave_, NGW = F.G * 8;
    constexpr int I_IN = (D / 64) * (INW / 32), I_D = (D / 64) * (D / 32), I_UP = (D / 64) * (FF / 32), I_DN = (FF / 64) * (D / 32);
    constexpr int NITEMS = I_IN + 3 * I_D + I_UP + I_DN;
    bf16_t* WinT = (bf16_t*)(F.ws + WS_WIN); bf16_t* WoabT = (bf16_t*)(F.ws + WS_WOAB); bf16_t* WoutT = (bf16_t*)(F.ws + WS_WOUT);
    bf16_t* WupT = (bf16_t*)(F.ws + WS_WUP); bf16_t* WdownT = (bf16_t*)(F.ws + WS_WDOWN);
    for (int it = gw; it < NITEMS; it += NGW) {
        int r = it;
        if (r < I_IN) { p0_transpose_item(F.w_in, D, INW, WinT, 0, nullptr, scr, r, lane_); continue; } r -= I_IN;
        if (r < I_D) { p0_transpose_item(F.w_oa, D, D, WoabT, 0, nullptr, scr, r, lane_); continue; } r -= I_D;
        if (r < I_D) { p0_transpose_item(F.w_ob, D, D, WoabT, D, nullptr, scr, r, lane_); continue; } r -= I_D;
        if (r < I_D) { p0_transpose_item(F.w_out, D, D, WoutT, 0, nullptr, scr, r, lane_); continue; } r -= I_D;
        if (r < I_UP) { p0_transpose_item(F.w_up, D, FF, WupT, 0, F.g2, scr, r, lane_); continue; } r -= I_UP;
        p0_transpose_item(F.w_down, FF, D, WdownT, 0, nullptr, scr, r, lane_);
    }
    bf16_t* XN = (bf16_t*)(F.ws + WS_XN); bf16_t* XNs = (bf16_t*)(F.ws + WS_XNS);
    for (int m = gw; m < MP + NS; m += NGW) {
        if (m < MP) rms_row_to_bf16(F.xp + (size_t)m * D, F.g1, XN + (size_t)m * D, lane_);
        else rms_row_to_bf16(F.xs + (size_t)(m - MP) * D, F.g1, XNs + (size_t)(m - MP) * D, lane_);
    }
    bf16_t* Wt = (bf16_t*)(F.ws + WS_WTRIL);
    for (int i = F.bid * 512 + tid_; i < 8 * 128 * 128; i += F.G * 512) { const int t = (i >> 7) & 127, s = i & 127; const float v = (s <= t) ? F.sgu_w[i] : 0.f; Wt[i] = (bf16_t)(cvt_pk_bf16(v, 0.f) & 0xffffu); }
}

__device__ __forceinline__ f32x4 skinny(const bf16_t* A, int lda, const bf16_t* Bt, int ldb, int K, int wave, int lane) {
    const int l15 = lane & 15, g = lane >> 4;
    const bf16_t* ap = A + (size_t)(16 * wave + l15) * lda + 8 * g; const bf16_t* bp = Bt + (size_t)l15 * ldb + 8 * g;
    f32x4 acc0 = {0.f, 0.f, 0.f, 0.f}, acc1 = {0.f, 0.f, 0.f, 0.f};
#pragma unroll 4
    for (int k = 0; k < K; k += 64) {
        const bf16x8 a0 = *(const bf16x8*)(ap + k), b0 = *(const bf16x8*)(bp + k), a1 = *(const bf16x8*)(ap + k + 32), b1 = *(const bf16x8*)(bp + k + 32);
        acc0 = MFMA16(b0, a0, acc0); acc1 = MFMA16(b1, a1, acc1);
    }
    return acc0 + acc1;
}
__device__ __forceinline__ float act_in(float v, int col) { return col < C_Q ? gelu_t(v) : (col < C_GA ? v : sigmoid_f(v)); }

constexpr int KP = 72;
__device__ __forceinline__ void attn_unit(const Ctx& F, LAS unsigned char* lds, bf16_t* H, int b, int kvh, int qb) {
    const int tid_ = opaque_tid(), lane_ = tid_ & 63, wave_ = __builtin_amdgcn_readfirstlane(tid_ >> 6);
    LAS bf16_t* Ks = (LAS bf16_t*)lds; LAS bf16_t* Vs = (LAS bf16_t*)(lds + 256 * KP * 2);
    const int tid = tid_, lane = lane_, l15 = lane & 15, g = lane >> 4, qt = wave_;
    const long rowbase = (long)b * SEQ + (long)(qb - 1) * 128;
#pragma unroll
    for (int i = 0; i < 4; ++i) { const int c = tid + 512 * i, j = c >> 3, ch = c & 7;
        u32x4 kv = {0u, 0u, 0u, 0u}, vv = {0u, 0u, 0u, 0u};
        if (qb > 0 || j >= 128) { const bf16_t* p = H + (size_t)(rowbase + j) * INW + C_K + kvh * 64 + ch * 8; kv = *(const u32x4*)p; vv = *(const u32x4*)(p + 256); }
        *(LAS u32x4*)(Ks + j * KP + ch * 8) = kv; *(LAS u32x4*)(Vs + j * KP + ch * 8) = vv; }
    if (tid < 128) *(LAS u32x4*)(Vs + (256 + (tid >> 3)) * KP + (tid & 7) * 8) = (u32x4){0u, 0u, 0u, 0u};
    __syncthreads();
    const int qq = l15 >> 2, pp = lane & 3;
    for (int hh = 0; hh < 4; ++hh) {
        const int h = kvh * 4 + hh; const float slope = __builtin_amdgcn_exp2f(-0.5f * (float)(h + 1)); const float sink = F.sinks[h];
        bf16_t* qp = H + (size_t)(b * SEQ + qb * 128 + 16 * qt + l15) * INW + C_Q + h * 64;
        const bf16x8 q0 = *(const bf16x8*)(qp + 8 * g), q1 = *(const bf16x8*)(qp + 8 * g + 32);
        f32x4 st[9];
#pragma unroll
        for (int kt = 0; kt < 9; ++kt) { const LAS bf16_t* kp = Ks + (16 * (qt + kt) + l15) * KP + 8 * g;
            const bf16x8 k0 = *(const LAS bf16x8*)kp, k1 = *(const LAS bf16x8*)(kp + 32);
            f32x4 z = {0.f, 0.f, 0.f, 0.f}; z = MFMA16(k0, q0, z); st[kt] = MFMA16(k1, q1, z); }
        float mx = sink;
#pragma unroll
        for (int kt = 0; kt < 9; ++kt)
#pragma unroll
            for (int i = 0; i < 4; ++i) { const int diff = 128 + l15 - 16 * kt - 4 * g - i; const int j = 16 * (qt + kt) + 4 * g + i;
                const bool valid = (diff >= 0) && (diff <= 128) && (qb > 0 || j >= 128);
                const float s = valid ? (st[kt][i] * 0.125f - slope * (float)diff) : -1e30f; st[kt][i] = s; mx = fmaxf(mx, s); }
        mx = fmaxf(mx, __shfl_xor(mx, 16)); mx = fmaxf(mx, __shfl_xor(mx, 32));
        float sum = 0.f;
#pragma unroll
        for (int kt = 0; kt < 9; ++kt)
#pragma unroll
            for (int i = 0; i < 4; ++i) { const float p = __builtin_amdgcn_exp2f((st[kt][i] - mx) * LOG2E); st[kt][i] = p; sum += p; }
        sum += __shfl_xor(sum, 16); sum += __shfl_xor(sum, 32);
        sum += __builtin_amdgcn_exp2f((sink - mx) * LOG2E);
        const float inv = 1.0f / sum;
        f32x4 o[4];
#pragma unroll
        for (int c = 0; c < 4; ++c) o[c] = (f32x4){0.f, 0.f, 0.f, 0.f};
#pragma unroll
        for (int ks = 0; ks < 5; ++ks) {
            u32x4 pw; pw.x = cvt_pk_bf16(st[2 * ks][0] * inv, st[2 * ks][1] * inv); pw.y = cvt_pk_bf16(st[2 * ks][2] * inv, st[2 * ks][3] * inv);
            if (ks < 4) { pw.z = cvt_pk_bf16(st[2 * ks + 1][0] * inv, st[2 * ks + 1][1] * inv); pw.w = cvt_pk_bf16(st[2 * ks + 1][2] * inv, st[2 * ks + 1][3] * inv); } else { pw.z = 0u; pw.w = 0u; }
            const bf16x8 pf = __builtin_bit_cast(bf16x8, pw);
            const LAS bf16_t* vb = Vs + (16 * (qt + 2 * ks) + 4 * g + qq) * KP + 4 * pp;
#pragma unroll
            for (int c = 0; c < 4; ++c) { const s16x4 lo = tr_read(vb + 16 * c), hi = tr_read(vb + 16 * KP + 16 * c);
                const bf16x8 vf = {lo[0], lo[1], lo[2], lo[3], hi[0], hi[1], hi[2], hi[3]};
                o[c] = MFMA16(vf, pf, o[c]); }
        }
#pragma unroll
        for (int c = 0; c < 4; ++c) { u32x2 w; w.x = cvt_pk_bf16(o[c][0], o[c][1]); w.y = cvt_pk_bf16(o[c][2], o[c][3]); *(u32x2*)(qp + 16 * c + 4 * g) = w; }
    }
    __syncthreads();
}

constexpr int VNP = 136;
__device__ __forceinline__ void sgu_unit(const Ctx& F, LAS unsigned char* lds, bf16_t* H, const float* vss, const bf16_t* Wt, int b, int ch_, int gi) {
    const int tid_ = opaque_tid(), lane_ = tid_ & 63, wave_ = __builtin_amdgcn_readfirstlane(tid_ >> 6);
    LAS bf16_t* VN = (LAS bf16_t*)lds; LAS float* rs = (LAS float*)(lds + 128 * VNP * 2);
    const int tid = tid_, lane = lane_, l15 = lane & 15, g = lane >> 4, tt = wave_;
    const size_t rowbase = (size_t)b * SEQ + (size_t)ch_ * 128;
    if (tid < 128) { const f32x4* sp = (const f32x4*)(vss + (rowbase + tid) * 16); const f32x4 s4 = (sp[0] + sp[1]) + (sp[2] + sp[3]);
        rs[tid] = 1.0f / sqrtf(((s4[0] + s4[1]) + (s4[2] + s4[3])) * (1.0f / D) + EPS); }
    __syncthreads();
    { const int cc = tid & 15; const f32x4 g0 = *(const f32x4*)(F.gs + gi * 128 + cc * 8), g1v = *(const f32x4*)(F.gs + gi * 128 + cc * 8 + 4);
#pragma unroll
      for (int i = 0; i < 4; ++i) { const int s = (tid >> 4) + 32 * i; const float r = rs[s];
          const u32x4 w = *(const u32x4*)(H + (rowbase + s) * INW + C_V + gi * 128 + cc * 8);
          u32x4 o; o.x = cvt_pk_bf16(bflo(w.x) * r * g0[0], bfhi(w.x) * r * g0[1]); o.y = cvt_pk_bf16(bflo(w.y) * r * g0[2], bfhi(w.y) * r * g0[3]);
          o.z = cvt_pk_bf16(bflo(w.z) * r * g1v[0], bfhi(w.z) * r * g1v[1]); o.w = cvt_pk_bf16(bflo(w.w) * r * g1v[2], bfhi(w.w) * r * g1v[3]);
          *(LAS u32x4*)(VN + s * VNP + cc * 8) = o; } }
    __syncthreads();
    const int nks = (tt >> 1) + 1; const int qq = l15 >> 2, pp = lane & 3;
    bf16x8 wf[4];
#pragma unroll
    for (int ks = 0; ks < 4; ++ks) wf[ks] = (ks < nks) ? *(const bf16x8*)(Wt + ((size_t)gi * 128 + 16 * tt + l15) * 128 + 32 * ks + 8 * g) : (bf16x8){0, 0, 0, 0, 0, 0, 0, 0};
    const float bias = F.sgu_b[gi * 128 + 16 * tt + l15];
    bf16_t* up = H + (rowbase + 16 * tt + l15) * INW + C_U + gi * 128 + 4 * g;
#pragma unroll
    for (int c = 0; c < 8; ++c) { f32x4 acc = {0.f, 0.f, 0.f, 0.f};
#pragma unroll
        for (int ks = 0; ks < 4; ++ks) if (ks < nks) { const LAS bf16_t* vb = VN + (32 * ks + 8 * g + qq) * VNP + 16 * c + 4 * pp;
            const s16x4 lo = tr_read(vb), hi = tr_read(vb + 4 * VNP);
            const bf16x8 vf = {lo[0], lo[1], lo[2], lo[3], hi[0], hi[1], hi[2], hi[3]};
            acc = MFMA16(vf, wf[ks], acc); }
        const u32x2 uw = *(const u32x2*)(up + 16 * c);
        u32x2 w; w.x = cvt_pk_bf16(bflo(uw.x) * (acc[0] + bias), bfhi(uw.x) * (acc[1] + bias)); w.y = cvt_pk_bf16(bflo(uw.y) * (acc[2] + bias), bfhi(uw.y) * (acc[3] + bias));
        *(u32x2*)(up + 16 * c) = w; }
    __syncthreads();
}

__device__ __forceinline__ void sample_row(const Ctx& F, LAS unsigned char* lds, int b) {
    const int tid_ = opaque_tid(), lane_ = tid_ & 63, wave_ = __builtin_amdgcn_readfirstlane(tid_ >> 6);
    LAS float* qs = (LAS float*)lds;
    LAS float* sc = qs + 1024;
    LAS float* red = sc + 16 * 132;
    const int tid = tid_, lane = lane_;
    const float* Hs = (const float*)(F.ws + WS_HS) + (size_t)b * INW; bf16_t* ABs = (bf16_t*)(F.ws + WS_ABS) + (size_t)b * 2048;
    const int d0 = tid * 2; const float gv0 = Hs[C_V + d0], gv1 = Hs[C_V + d0 + 1];
    float ss = wave_sum(gv0 * gv0 + gv1 * gv1); if (lane == 0) red[wave_] = ss;
    qs[tid] = Hs[C_Q + tid]; qs[tid + 512] = Hs[C_Q + tid + 512];
    __syncthreads();
    { float tot = 0.f;
#pragma unroll
      for (int w = 0; w < 8; ++w) tot += red[w];
      const float r = 1.0f / sqrtf(tot * (1.0f / D) + EPS); const int gi = d0 >> 7;
      const float vn0 = gv0 * r * F.gs[d0], vn1 = gv1 * r * F.gs[d0 + 1];
      F.out[O_SGV + (size_t)b * D + d0] = vn0; F.out[O_SGV + (size_t)b * D + d0 + 1] = vn1;
      const float w00 = F.sgu_w[gi * 16384], b0 = F.sgu_b[gi * 128];
      *(unsigned*)(ABs + d0) = cvt_pk_bf16(Hs[C_U + d0] * (w00 * vn0 + b0), Hs[C_U + d0 + 1] * (w00 * vn1 + b0)); }
    const int h = tid >> 5, jj = tid & 31, kvh = h >> 2; const float slope = __builtin_amdgcn_exp2f(-0.5f * (float)(h + 1)); const float sink = F.sinks[h];
    const LAS f32x4* q4 = (const LAS f32x4*)(qs + h * 64);
    float sv[5]; float mx = sink;
#pragma unroll
    for (int r = 0; r < 4; ++r) { const int j = jj + 32 * r; const f32x4* kp = (const f32x4*)(F.ck + ((size_t)(b * 128 + j) * 4 + kvh) * 64); float dot = 0.f;
#pragma unroll
        for (int e = 0; e < 16; ++e) { const f32x4 kk = kp[e], q = q4[e]; dot += (kk.x * q.x + kk.y * q.y) + (kk.z * q.z + kk.w * q.w); }
        sv[r] = dot * 0.125f - slope * (float)(128 - j); mx = fmaxf(mx, sv[r]); }
    { const f32x4* kp = (const f32x4*)(Hs + C_K + kvh * 64); float dot = 0.f;
#pragma unroll
      for (int e = 0; e < 16; ++e) { const f32x4 kk = kp[e], q = q4[e]; dot += (kk.x * q.x + kk.y * q.y) + (kk.z * q.z + kk.w * q.w); }
      sv[4] = (jj == 0) ? dot * 0.125f : -1e30f; mx = fmaxf(mx, sv[4]); }
#pragma unroll
    for (int o = 1; o < 32; o <<= 1) mx = fmaxf(mx, __shfl_xor(mx, o));
    float sum = 0.f;
#pragma unroll
    for (int r = 0; r < 5; ++r) { sv[r] = __builtin_amdgcn_exp2f((sv[r] - mx) * LOG2E); sum += sv[r]; }
#pragma unroll
    for (int o = 1; o < 32; o <<= 1) sum += __shfl_xor(sum, o);
    sum += __builtin_amdgcn_exp2f((sink - mx) * LOG2E);
    const float inv = 1.0f / sum;
#pragma unroll
    for (int r = 0; r < 4; ++r) sc[h * 132 + jj + 32 * r] = sv[r] * inv;
    if (jj == 0) sc[h * 132 + 128] = sv[4] * inv;
    __syncthreads();
    { const int d2 = jj * 2; float o0 = 0.f, o1 = 0.f; const float* vp = F.cv + ((size_t)b * 128 * 4 + kvh) * 64 + d2;
#pragma unroll 8
      for (int j = 0; j < 128; ++j) { const float p = sc[h * 132 + j]; const f32x2 v = *(const f32x2*)(vp + (size_t)j * 256); o0 += p * v.x; o1 += p * v.y; }
      const float p = sc[h * 132 + 128]; o0 += p * Hs[C_VA + kvh * 64 + d2]; o1 += p * Hs[C_VA + kvh * 64 + d2 + 1];
      *(unsigned*)(ABs + 1024 + h * 64 + d2) = cvt_pk_bf16(o0, o1); }
    __syncthreads();
}

#define PHASE_IDS const int tid_ = opaque_tid(), lane = tid_ & 63, wave = __builtin_amdgcn_readfirstlane(tid_ >> 6), l15 = lane & 15, g4 = lane >> 4; (void)l15; (void)g4; (void)wave;
__global__ void __launch_bounds__(512, 2) fwd_megakernel(Args args) {
    extern __shared__ __attribute__((aligned(16))) unsigned char lds_raw[];
    LAS unsigned char* lds = (LAS unsigned char*)lds_raw;
    cg::grid_group grid = cg::this_grid();
    Ctx F;
    F.xp = args.in[0]; F.xs = args.in[1]; F.ck = args.in[2]; F.cv = args.in[3]; F.g1 = args.in[4]; F.w_in = args.in[5]; F.gs = args.in[6]; F.sgu_w = args.in[7];
    F.sgu_b = args.in[8]; F.sinks = args.in[9]; F.w_oa = args.in[10]; F.w_ob = args.in[11]; F.w_out = args.in[12]; F.g2 = args.in[13]; F.w_up = args.in[14];
    F.w_down = args.in[15]; F.gf = args.in[16]; F.out = args.out; F.ws = args.ws;
    F.G = gridDim.x; F.bid = blockIdx.x;
    unsigned char* ws = args.ws;
    float* vss = (float*)(ws + WS_VSS); float* x1ss = (float*)(ws + WS_X1SS);
    bf16_t* H = (bf16_t*)(ws + WS_H); bf16_t* XN = (bf16_t*)(ws + WS_XN); bf16_t* T1 = (bf16_t*)(ws + WS_T1); bf16_t* X1B = (bf16_t*)(ws + WS_X1B); bf16_t* Fb = (bf16_t*)(ws + WS_F);
    bf16_t* WinT = (bf16_t*)(ws + WS_WIN); bf16_t* WoabT = (bf16_t*)(ws + WS_WOAB); bf16_t* WoutT = (bf16_t*)(ws + WS_WOUT); bf16_t* WupT = (bf16_t*)(ws + WS_WUP); bf16_t* WdownT = (bf16_t*)(ws + WS_WDOWN);
    bf16_t* XNs = (bf16_t*)(ws + WS_XNS); float* Hs = (float*)(ws + WS_HS); bf16_t* ABs = (bf16_t*)(ws + WS_ABS); bf16_t* Hgs = (bf16_t*)(ws + WS_HGS);
    float* X1s = (float*)(ws + WS_X1S); bf16_t* X1Bs = (bf16_t*)(ws + WS_X1BS); bf16_t* Fs = (bf16_t*)(ws + WS_FS); float* Ds = (float*)(ws + WS_DS);
    const bf16_t* Wt = (const bf16_t*)(ws + WS_WTRIL);
    float* y = F.out + O_YP;

    p0_prologue(F, lds);
    grid.sync();

    { PHASE_IDS
    for (int it = F.bid; it < INW / 16; it += F.G) { const int n0 = it * 16;
        const f32x4 acc = skinny(XNs, D, WinT + (size_t)n0 * D, D, D, wave, lane);
        const int row = 16 * wave + l15, col = n0 + 4 * g4; f32x4 o;
#pragma unroll
        for (int i = 0; i < 4; ++i) o[i] = act_in(acc[i], col);
        *(f32x4*)(Hs + (size_t)row * INW + col) = o; } }
    __syncthreads();
    { pg8::Gemm g{XN, WinT, D, D, 0, 0}; pg8::StaticOrder S; S.init(MP, INW, F.G, F.bid, 1); pg8::EpiIn E{H, vss};
      pg8::gemm_phase<pg8::EpiIn, pg8::StaticOrder, true, true>(lds, g, S, E); }
    grid.sync();

    { PHASE_IDS const int gt = F.bid * 512 + tid_, GT = F.G * 512;
      for (int idx = gt; idx < 128 * 128 * 64; idx += GT) { const int b = idx >> 13, w = (idx >> 6) & 127, c4 = idx & 63;
          f32x4 kv, vv;
          if (w < 127) { kv = *(const f32x4*)(F.ck + ((size_t)(b * 128 + w + 1) * 256 + c4 * 4)); vv = *(const f32x4*)(F.cv + ((size_t)(b * 128 + w + 1) * 256 + c4 * 4)); }
          else { kv = *(const f32x4*)(Hs + (size_t)b * INW + C_K + c4 * 4); vv = *(const f32x4*)(Hs + (size_t)b * INW + C_VA + c4 * 4); }
          *(f32x4*)(F.out + O_KWS + (size_t)idx * 4) = kv; *(f32x4*)(F.out + O_VWS + (size_t)idx * 4) = vv; }
      for (int idx = gt; idx < 4 * 128 * 64; idx += GT) { const int b = idx >> 13, w = (idx >> 6) & 127, c8 = idx & 63;
          const u32x4 wv = *(const u32x4*)(H + (size_t)(b * SEQ + SEQ - 128 + w) * INW + C_K + c8 * 8);
          float* op = F.out + (c8 < 32 ? O_KWP : O_VWP) + (size_t)(b * 128 + w) * 256 + (c8 & 31) * 8;
          *(f32x4*)op = (f32x4){bflo(wv.x), bfhi(wv.x), bflo(wv.y), bfhi(wv.y)}; *(f32x4*)(op + 4) = (f32x4){bflo(wv.z), bfhi(wv.z), bflo(wv.w), bfhi(wv.w)}; }
    }
    for (int it = F.bid; it < 512 + 1024 + 128; it += F.G) {
        if (it < 512) { const int qb = it & 31, kvh = (it >> 5) & 3, b = it >> 7; attn_unit(F, lds, H, b, kvh, qb); }
        else if (it < 1536) { const int r = it - 512; const int gi = r & 7, ch = (r >> 3) & 31, b = r >> 8; sgu_unit(F, lds, H, vss, Wt, b, ch, gi); }
        else sample_row(F, lds, it - 1536);
    }
    grid.sync();

    { PHASE_IDS
    for (int it = F.bid; it < D / 16; it += F.G) { const int n0 = it * 16;
        const f32x4 accA = skinny(ABs, 2048, WoabT + (size_t)n0 * D, D, D, wave, lane);
        const f32x4 accB = skinny(ABs + 1024, 2048, WoabT + (size_t)(1024 + n0) * D, D, D, wave, lane);
        const int row = 16 * wave + l15, col = n0 + 4 * g4;
        const f32x4 ga = *(const f32x4*)(Hs + (size_t)row * INW + C_GA + col), gb = *(const f32x4*)(Hs + (size_t)row * INW + C_GB + col);
        const f32x4 hv = ga * accA + gb * accB; u32x2 w; w.x = cvt_pk_bf16(hv[0], hv[1]); w.y = cvt_pk_bf16(hv[2], hv[3]);
        *(u32x2*)(Hgs + (size_t)row * D + col) = w; } }
    __syncthreads();
    { pg8::Gemm g{H + C_U, WoabT, INW, D, (size_t)(C_Q - C_U) * 2, 4}; pg8::StaticOrder S; S.init(MP, D, F.G, F.bid, 2); pg8::EpiOab E{H, T1};
      pg8::gemm_phase<pg8::EpiOab, pg8::StaticOrder, true, true>(lds, g, S, E); }
    grid.sync();

    { PHASE_IDS
    for (int it = F.bid; it < D / 16; it += F.G) { const int n0 = it * 16;
        const f32x4 acc = skinny(Hgs, D, WoutT + (size_t)n0 * D, D, D, wave, lane);
        const int row = 16 * wave + l15, col = n0 + 4 * g4;
        const f32x4 v = acc + *(const f32x4*)(F.xs + (size_t)row * D + col);
        *(f32x4*)(X1s + (size_t)row * D + col) = v; u32x2 w; w.x = cvt_pk_bf16(v[0], v[1]); w.y = cvt_pk_bf16(v[2], v[3]); *(u32x2*)(X1Bs + (size_t)row * D + col) = w; } }
    __syncthreads();
    { pg8::Gemm g{T1, WoutT, D, D, 0, 0}; pg8::StaticOrder S; S.init(MP, D, F.G, F.bid, 1); pg8::EpiOut E{F.xp, y, X1B, x1ss};
      pg8::gemm_phase<pg8::EpiOut, pg8::StaticOrder, true, true>(lds, g, S, E); }
    grid.sync();

    { PHASE_IDS
    for (int it = F.bid; it < FF / 16; it += F.G) { const int n0 = it * 16;
        const f32x4 acc = skinny(X1Bs, D, WupT + (size_t)n0 * D, D, D, wave, lane);
        const int row = 16 * wave + l15, col = n0 + 4 * g4; f32x4 v;
#pragma unroll
        for (int i = 0; i < 4; ++i) { const float a = fmaxf(acc[i], 0.f); v[i] = a * a; }
        u32x2 w; w.x = cvt_pk_bf16(v[0], v[1]); w.y = cvt_pk_bf16(v[2], v[3]); *(u32x2*)(Fs + (size_t)row * FF + col) = w; } }
    __syncthreads();
    { pg8::Gemm g{X1B, WupT, D, D, 0, 0}; pg8::StaticOrder S; S.init(MP, FF, F.G, F.bid, 1); pg8::EpiUp E{Fb};
      pg8::gemm_phase<pg8::EpiUp, pg8::StaticOrder, true, true>(lds, g, S, E); }
    grid.sync();

    { PHASE_IDS
    for (int it = F.bid; it < 256; it += F.G) { const int n0 = (it & 63) * 16, ks = it >> 6;
        const f32x4 acc = skinny(Fs + ks * 1024, FF, WdownT + (size_t)n0 * FF + ks * 1024, FF, 1024, wave, lane);
        const int row = 16 * wave + l15, col = n0 + 4 * g4;
        *(f32x4*)(Ds + ((size_t)ks * NS + row) * D + col) = acc; } }
    __syncthreads();
    { pg8::Gemm g{Fb, WdownT, FF, FF, 0, 0}; pg8::StaticOrder S; S.init(MP, D, F.G, F.bid, 1); pg8::EpiDown E{y, x1ss};
      pg8::gemm_phase<pg8::EpiDown, pg8::StaticOrder, true, true>(lds, g, S, E); }
    grid.sync();

    { PHASE_IDS const int gw = F.bid * 8 + wave, NGW = F.G * 8;
      for (int m = gw; m < MP + NS; m += NGW) {
          f32x4 v[4]; const f32x4* gr = (const f32x4*)F.gf + lane; float* orow;
          if (m < MP) { orow = y + (size_t)m * D; const f32x4* xr = (const f32x4*)orow + lane;
#pragma unroll
              for (int j = 0; j < 4; ++j) v[j] = xr[64 * j];
          } else { const int r = m - MP; orow = F.out + O_YS + (size_t)r * D; const f32x4* xr = (const f32x4*)(X1s + (size_t)r * D) + lane; float s1 = 0.f;
#pragma unroll
              for (int j = 0; j < 4; ++j) { v[j] = xr[64 * j]; s1 += (v[j].x * v[j].x + v[j].y * v[j].y) + (v[j].z * v[j].z + v[j].w * v[j].w); }
              const float r2 = 1.0f / (wave_sum(s1) * (1.0f / D) + EPS);
#pragma unroll
              for (int j = 0; j < 4; ++j) { f32x4 d = {0.f, 0.f, 0.f, 0.f};
#pragma unroll
                  for (int ks = 0; ks < 4; ++ks) d += ((const f32x4*)(Ds + ((size_t)ks * NS + r) * D) + lane)[64 * j];
                  v[j] += d * r2; }
          }
          float s = 0.f;
#pragma unroll
          for (int j = 0; j < 4; ++j) s += (v[j].x * v[j].x + v[j].y * v[j].y) + (v[j].z * v[j].z + v[j].w * v[j].w);
          const float rr = 1.0f / sqrtf(wave_sum(s) * (1.0f / D) + EPS);
#pragma unroll
          for (int j = 0; j < 4; ++j) ((f32x4*)orow + lane)[64 * j] = v[j] * rr * gr[64 * j];
      }
    }
}

extern "C" void kernel_launch(void* const* d_in, const int* in_sizes, int n_in, void* d_out, int out_size, void* d_ws, size_t ws_size, hipStream_t stream) {
    static int grid = 0;
    if (grid == 0) {
        if (n_in != 17 || in_sizes[0] != MP * D || (size_t)out_size != O_END || ws_size < WS_END) {
            fprintf(stderr, "kernel_launch: unexpected shapes: n_in %d in0 %d out %d ws %zu\n", n_in, n_in > 0 ? in_sizes[0] : -1, out_size, ws_size); grid = -1; return; }
        int dev = 0, cus = 0, per_cu = 0;
        hipGetDevice(&dev); hipDeviceGetAttribute(&cus, hipDeviceAttributeMultiprocessorCount, dev);
        if (hipFuncSetAttribute((const void*)fwd_megakernel, hipFuncAttributeMaxDynamicSharedMemorySize, LDS_BYTES) != hipSuccess) { fprintf(stderr, "kernel_launch: hipFuncSetAttribute failed\n"); grid = -1; return; }
        if (hipOccupancyMaxActiveBlocksPerMultiprocessor(&per_cu, (const void*)fwd_megakernel, 512, LDS_BYTES) != hipSuccess || per_cu < 1) { fprintf(stderr, "kernel_launch: occupancy query gave %d\n", per_cu); per_cu = 1; }
        (void)hipGetLastError();
        grid = cus * 1;
        if (grid > 256) grid = 256;
    }
    if (grid < 0) return;
    Args a{};
    for (int i = 0; i < 17; ++i) a.in[i] = (const float*)d_in[i];
    a.out = (float*)d_out; a.ws = (unsigned char*)d_ws;
    void* kargs[] = {&a};
    hipError_t e = hipLaunchCooperativeKernel((const void*)fwd_megakernel, dim3(grid), dim3(512), kargs, LDS_BYTES, stream);
    if (e != hipSuccess) fprintf(stderr, "kernel_launch: cooperative launch failed: %s (grid %d)\n", hipGetErrorString(e), grid);
}
```

```cpp
#include <hip/hip_runtime.h>
#include <hip/hip_cooperative_groups.h>
#include <cstdio>
#include <cstdint>
namespace cg = cooperative_groups;

#define LAS __attribute__((address_space(3)))
#define PG8_LAS __attribute__((address_space(3)))
typedef unsigned short bf16_t;
typedef short bf16x8 __attribute__((ext_vector_type(8)));
typedef short s16x4 __attribute__((ext_vector_type(4)));
typedef float f32x4 __attribute__((ext_vector_type(4)));
typedef float f32x2 __attribute__((ext_vector_type(2)));
typedef unsigned u32x4 __attribute__((ext_vector_type(4)));
typedef unsigned u32x2 __attribute__((ext_vector_type(2)));

constexpr int D = 1024, SEQ = 4096, NBATCH = 4, MP = NBATCH * SEQ, NS = 128, INW = 5632, FF = 4096;
constexpr int C_U = 0, C_V = 1024, C_Q = 2048, C_K = 3072, C_VA = 3328, C_GA = 3584, C_GB = 4608;
constexpr float EPS = 1e-6f;
constexpr float LOG2E = 1.4426950408889634f;
constexpr size_t O_YP = 0, O_YS = (size_t)MP * D, O_KWP = O_YS + (size_t)NS * D, O_VWP = O_KWP + 131072, O_KWS = O_VWP + 131072,
                 O_VWS = O_KWS + 4194304, O_SGV = O_VWS + 4194304, O_END = O_SGV + 131072;
constexpr size_t KiB = 1024, MiB = 1024 * 1024;
constexpr size_t WS_VSS = 0, WS_X1SS = 1 * MiB;
constexpr size_t WS_XNS = 2 * MiB, WS_HS = WS_XNS + 256 * KiB, WS_ABS = 5 * MiB, WS_HGS = WS_ABS + 512 * KiB, WS_X1S = WS_HGS + 256 * KiB,
                 WS_X1BS = WS_X1S + 512 * KiB, WS_FS = WS_X1BS + 256 * KiB, WS_DS = WS_FS + 1 * MiB, WS_WTRIL = WS_DS + 2 * MiB;
constexpr size_t WS_WIN = 10 * MiB, WS_WOAB = 21 * MiB, WS_WOUT = 25 * MiB, WS_WUP = 27 * MiB, WS_WDOWN = 35 * MiB;
constexpr size_t WS_H = 44 * MiB, WS_X1B = WS_H, WS_F = WS_H + 32 * MiB, WS_XN = 220 * MiB, WS_T1 = WS_XN, WS_END = 252 * MiB;
static_assert(WS_HS + (size_t)NS * INW * 4 <= WS_ABS && WS_WTRIL + 256 * KiB <= WS_WIN && WS_WIN + (size_t)INW * D * 2 <= WS_WOAB, "ws map");
static_assert(WS_H + (size_t)MP * INW * 2 <= WS_XN && WS_F + (size_t)MP * FF * 2 <= WS_XN, "ws map 2");
constexpr size_t WS_BAR = WS_WTRIL + 256 * KiB;
static_assert(WS_BAR + 16384 <= WS_WIN, "ws map 3");
constexpr int LDS_BYTES = 147456;

__device__ __forceinline__ unsigned cvt_pk_bf16(float lo, float hi) { unsigned r; asm volatile("v_cvt_pk_bf16_f32 %0, %1, %2" : "=v"(r) : "v"(lo), "v"(hi)); return r; }
__device__ __forceinline__ float bflo(unsigned w) { return __uint_as_float(w << 16); }
__device__ __forceinline__ float bfhi(unsigned w) { return __uint_as_float(w & 0xffff0000u); }
__device__ __forceinline__ float bf1(bf16_t h) { return __uint_as_float(((unsigned)h) << 16); }
__device__ __forceinline__ float gelu_t(float x) {
    const float u = x * (1.0f + 0.044715f * x * x);
    const float e = __builtin_amdgcn_exp2f(-2.302208198f * u);
    return x * __builtin_amdgcn_rcpf(1.0f + e);
}
__device__ __forceinline__ float sigmoid_f(float x) { return __builtin_amdgcn_rcpf(1.0f + __builtin_amdgcn_exp2f(-LOG2E * x)); }
__device__ __forceinline__ int opaque_tid() { int t = threadIdx.x; asm volatile("" : "+v"(t)); return t; }
__device__ __forceinline__ float wave_sum(float v) {
#pragma unroll
    for (int o = 1; o < 64; o <<= 1) v += __shfl_xor(v, o);
    return v;
}
__device__ __forceinline__ s16x4 tr_read(const LAS bf16_t* p) {
    typedef short v4i16_t __attribute__((ext_vector_type(4)));
    return __builtin_bit_cast(s16x4, __builtin_amdgcn_ds_read_tr16_b64_v4i16((LAS v4i16_t*)p));
}

namespace pg8 {
constexpr int BM = 256, BK = 64, HALF = 128, HTB = HALF * BK * 2, STAGE_BYTES = 8 * HTB, NXCD = 8, WGM = 8;
__host__ __device__ __forceinline__ int lds_byte(int r, int c) { const int st = (r >> 4) * 2 + (c >> 5), rr = r & 15, cc = c & 31, ob = rr * 64 + cc * 2; return st * 1024 + (ob ^ (((ob >> 9) & 1) << 5)); }
__host__ __device__ __forceinline__ void stage_rc(int b, int& R, int& C) { const int st = b / 1024, sb = b % 1024, swz = sb ^ (((sb >> 9) & 1) << 5); R = (st >> 1) * 16 + swz / 64; C = (st & 1) * 32 + (swz % 64) / 2; }
__host__ __device__ __forceinline__ int perm32(int rho) { const int n = rho >> 4, i = rho & 15; return 8 * (i >> 2) + 4 * n + (i & 3); }

struct Unit { int pm, pn, sub; };
struct Gemm { const bf16_t* A; const bf16_t* Bt; int lda, K; size_t a_sub_off; int b_sub_tiles; };

struct StaticOrder {
    int nM, nN, nwg, G, c, nsub;
    __host__ __device__ void init(int M, int N, int G_, int c_, int nsub_) { nM = M / BM; nN = N / BM; nwg = nM * nN; G = G_; c = c_; nsub = nsub_; }
    __host__ __device__ bool next(int i, Unit& u) const {
        const int j = i / nsub; u.sub = i - j * nsub;
        const long L = (long)j * G + c; if (L >= nwg) return false;
        int wgid = (int)L; { const int q = nwg / NXCD, r = nwg % NXCD, xcd = wgid % NXCD, off = wgid / NXCD; wgid = (xcd < r ? xcd * (q + 1) : r * (q + 1) + (xcd - r) * q) + off; }
        const int nig = WGM * nN, gid = wgid / nig, fm = gid * WGM, gsz = (nM - fm) < WGM ? (nM - fm) : WGM;
        u.pm = fm + ((wgid % nig) % gsz); u.pn = (wgid % nig) / gsz; return true;
    }
    __device__ __forceinline__ void a_ready(const Unit&) const {}
    __device__ __forceinline__ void done(const Unit&) const {}
};

__device__ __forceinline__ u32x4 pack8(const f32x4 v0, const f32x4 v1) { u32x4 w; w.x = cvt_pk_bf16(v0[0], v0[1]); w.y = cvt_pk_bf16(v0[2], v0[3]); w.z = cvt_pk_bf16(v1[0], v1[1]); w.w = cvt_pk_bf16(v1[2], v1[3]); return w; }

struct EpiIn {
    static constexpr bool PERM = true, AFTER_DRAIN = false;
    bf16_t* H; float* vss;
    __device__ __forceinline__ void operator()(const f32x4 (&acc)[2][2][4][2], const Unit& u, int wr, int wc, int fr, int fq) const {
        const int pn = u.pn; const int mode = pn < 8 ? 1 : (pn < 14 ? 0 : 2); const bool isv = (pn >= 4 && pn < 8);
        const int row0 = u.pm * BM + wr * 64 + fr, col0 = pn * BM + wc * 32 + 8 * fq;
#pragma unroll
        for (int ai = 0; ai < 2; ++ai)
#pragma unroll
            for (int m = 0; m < 4; ++m) { const int row = row0 + ai * HALF + m * 16; bf16_t* rowp = H + (size_t)row * INW + col0; float ss = 0.f;
#pragma unroll
                for (int bj = 0; bj < 2; ++bj) { f32x4 v0 = acc[ai][bj][m][0], v1 = acc[ai][bj][m][1];
                    if (mode == 1) {
#pragma unroll
                        for (int e = 0; e < 4; ++e) { v0[e] = gelu_t(v0[e]); v1[e] = gelu_t(v1[e]); }
                        if (isv) {
#pragma unroll
                            for (int e = 0; e < 4; ++e) ss += v0[e] * v0[e] + v1[e] * v1[e]; }
                    } else if (mode == 2) {
#pragma unroll
                        for (int e = 0; e < 4; ++e) { v0[e] = sigmoid_f(v0[e]); v1[e] = sigmoid_f(v1[e]); }
                    }
                    *(u32x4*)(rowp + bj * HALF) = pack8(v0, v1); }
                if (isv) { ss += __shfl_xor(ss, 16); ss += __shfl_xor(ss, 32); if (fq == 0) vss[(size_t)row * 16 + (pn - 4) * 4 + wc] = ss; }
            }
    }
};
struct EpiOab {
    static constexpr bool PERM = true, AFTER_DRAIN = false;
    const bf16_t* H; bf16_t* T1;
    __device__ __forceinline__ void operator()(const f32x4 (&acc)[2][2][4][2], const Unit& u, int wr, int wc, int fr, int fq) const {
        const int row0 = u.pm * BM + wr * 64 + fr, col0 = u.pn * BM + wc * 32 + 8 * fq; const int gcol = C_GA + u.sub * 1024 + col0; const bool second = u.sub != 0;
#pragma unroll
        for (int ai = 0; ai < 2; ++ai)
#pragma unroll
            for (int m = 0; m < 4; ++m) { const int row = row0 + ai * HALF + m * 16;
#pragma unroll
                for (int bj = 0; bj < 2; ++bj) {
                    const u32x4 gw = *(const u32x4*)(H + (size_t)row * INW + gcol + bj * HALF);
                    f32x4 v0 = acc[ai][bj][m][0], v1 = acc[ai][bj][m][1];
                    v0[0] *= bflo(gw.x); v0[1] *= bfhi(gw.x); v0[2] *= bflo(gw.y); v0[3] *= bfhi(gw.y);
                    v1[0] *= bflo(gw.z); v1[1] *= bfhi(gw.z); v1[2] *= bflo(gw.w); v1[3] *= bfhi(gw.w);
                    bf16_t* tp = T1 + (size_t)row * D + col0 + bj * HALF;
                    if (second) { const u32x4 tw = *(const u32x4*)tp;
                        v0[0] += bflo(tw.x); v0[1] += bfhi(tw.x); v0[2] += bflo(tw.y); v0[3] += bfhi(tw.y);
                        v1[0] += bflo(tw.z); v1[1] += bfhi(tw.z); v1[2] += bflo(tw.w); v1[3] += bfhi(tw.w); }
                    *(u32x4*)tp = pack8(v0, v1); }
            }
    }
};
struct EpiOut {
    static constexpr bool PERM = true, AFTER_DRAIN = false;
    const float* x; float* y; bf16_t* X1B; float* x1ss;
    __device__ __forceinline__ void operator()(const f32x4 (&acc)[2][2][4][2], const Unit& u, int wr, int wc, int fr, int fq) const {
        const int row0 = u.pm * BM + wr * 64 + fr, col0 = u.pn * BM + wc * 32 + 8 * fq;
#pragma unroll
        for (int ai = 0; ai < 2; ++ai)
#pragma unroll
            for (int m = 0; m < 4; ++m) { const int row = row0 + ai * HALF + m * 16; float ss = 0.f;
#pragma unroll
                for (int bj = 0; bj < 2; ++bj) { const size_t off = (size_t)row * D + col0 + bj * HALF;
                    const f32x4 v0 = acc[ai][bj][m][0] + *(const f32x4*)(x + off), v1 = acc[ai][bj][m][1] + *(const f32x4*)(x + off + 4);
                    *(f32x4*)(y + off) = v0; *(f32x4*)(y + off + 4) = v1; *(u32x4*)(X1B + off) = pack8(v0, v1);
#pragma unroll
                    for (int e = 0; e < 4; ++e) ss += v0[e] * v0[e] + v1[e] * v1[e]; }
                ss += __shfl_xor(ss, 16); ss += __shfl_xor(ss, 32); if (fq == 0) x1ss[(size_t)row * 16 + u.pn * 4 + wc] = ss;
            }
    }
};
struct EpiUp {
    static constexpr bool PERM = true, AFTER_DRAIN = false;
    bf16_t* F;
    __device__ __forceinline__ void operator()(const f32x4 (&acc)[2][2][4][2], const Unit& u, int wr, int wc, int fr, int fq) const {
        const int row0 = u.pm * BM + wr * 64 + fr, col0 = u.pn * BM + wc * 32 + 8 * fq;
#pragma unroll
        for (int ai = 0; ai < 2; ++ai)
#pragma unroll
            for (int m = 0; m < 4; ++m) { const int row = row0 + ai * HALF + m * 16;
#pragma unroll
                for (int bj = 0; bj < 2; ++bj) { f32x4 v0 = acc[ai][bj][m][0], v1 = acc[ai][bj][m][1];
#pragma unroll
                    for (int e = 0; e < 4; ++e) { const float a = fmaxf(v0[e], 0.f), b = fmaxf(v1[e], 0.f); v0[e] = a * a; v1[e] = b * b; }
                    *(u32x4*)(F + (size_t)row * FF + col0 + bj * HALF) = pack8(v0, v1); }
            }
    }
};
struct EpiDown {
    static constexpr bool PERM = true, AFTER_DRAIN = false;
    float* y; const float* x1ss;
    __device__ __forceinline__ void operator()(const f32x4 (&acc)[2][2][4][2], const Unit& u, int wr, int wc, int fr, int fq) const {
        const int row0 = u.pm * BM + wr * 64 + fr, col0 = u.pn * BM + wc * 32 + 8 * fq;
#pragma unroll
        for (int ai = 0; ai < 2; ++ai)
#pragma unroll
            for (int m = 0; m < 4; ++m) { const int row = row0 + ai * HALF + m * 16;
                const f32x4* sp = (const f32x4*)(x1ss + (size_t)row * 16); const f32x4 s4 = (sp[0] + sp[1]) + (sp[2] + sp[3]);
                const float r2 = 1.0f / (((s4[0] + s4[1]) + (s4[2] + s4[3])) * (1.0f / D) + EPS);
#pragma unroll
                for (int bj = 0; bj < 2; ++bj) { const size_t off = (size_t)row * D + col0 + bj * HALF;
                    const f32x4 v0 = *(const f32x4*)(y + off) + acc[ai][bj][m][0] * r2, v1 = *(const f32x4*)(y + off + 4) + acc[ai][bj][m][1] * r2;
                    *(f32x4*)(y + off) = v0; *(f32x4*)(y + off + 4) = v1; }
            }
    }
};

template <class Epi, class Sched, bool ALIGN_EPI = false, bool SP2 = false>
__device__ __forceinline__ void gemm_phase(PG8_LAS unsigned char* lds, const Gemm g, const Sched& S, const Epi& E) {
    const int tid = opaque_tid(), wid = __builtin_amdgcn_readfirstlane(tid >> 6), lane = tid & 63, wr = wid >> 2, wc = wid & 3, fr = lane & 15, fq = lane >> 4;
    const int K = g.K, nt = K / BK;
    unsigned voffA[2], voffB[2];
#pragma unroll
    for (int i = 0; i < 2; ++i) { int R, C; stage_rc(tid * 16 + i * 8192, R, C); const int Rb = Epi::PERM ? ((R & ~31) + perm32(R & 31)) : R;
        voffA[i] = (unsigned)(R * g.lda + C) * 2u; voffB[i] = (unsigned)(Rb * K + C) * 2u; }
    const size_t kstep = (size_t)(BK * 2);
    const size_t hstepA = (size_t)HALF * g.lda * 2, hstepB = (size_t)HALF * K * 2;
    const size_t tstepA = 2 * hstepA, tstepB = 2 * hstepB;
    const unsigned ldsw = (unsigned)wid * 1024u;
    const int aoff = lds_byte(wr * 64 + fr, fq * 8), boff = lds_byte(wc * 32 + fr, fq * 8);
#define PG8_SA(b, h) (((b) * 2 + (h)) * HTB)
#define PG8_SB(b, h) ((4 + (b) * 2 + (h)) * HTB)
#define PG8_STAGE(bufoff, gbase, voff) do { _Pragma("unroll") for (int _i = 0; _i < 2; ++_i) \
        __builtin_amdgcn_global_load_lds((const unsigned*)((const char*)(gbase) + (voff)[_i]), (PG8_LAS unsigned*)(lds + (bufoff) + ldsw + _i * 8192), 16, 0, 0); } while (0)
#define PG8_LDA(dst, b, h) do { _Pragma("unroll") for (int m = 0; m < 4; ++m) _Pragma("unroll") for (int k = 0; k < 2; ++k) dst[m][k] = *(const PG8_LAS bf16x8*)(lds + PG8_SA(b, h) + aoff + m * 2048 + k * 1024); } while (0)
#define PG8_LDB(dst, b, h) do { _Pragma("unroll") for (int n = 0; n < 2; ++n) _Pragma("unroll") for (int k = 0; k < 2; ++k) dst[n][k] = *(const PG8_LAS bf16x8*)(lds + PG8_SB(b, h) + boff + n * 2048 + k * 1024); } while (0)
#define PG8_MMA(ai, bj, At, Bt) do { __builtin_amdgcn_s_setprio(1); _Pragma("unroll") for (int m = 0; m < 4; ++m) _Pragma("unroll") for (int n = 0; n < 2; ++n) _Pragma("unroll") for (int k = 0; k < 2; ++k) \
        acc[ai][bj][m][n] = __builtin_amdgcn_mfma_f32_16x16x32_bf16(Bt[n][k], At[m][k], acc[ai][bj][m][n], 0, 0, 0); __builtin_amdgcn_s_setprio(0); } while (0)
#define PG8_WAIT_V(n) asm volatile("s_waitcnt vmcnt(" #n ")" ::: "memory")
#define PG8_WAIT_L(n) asm volatile("s_waitcnt lgkmcnt(" #n ")" ::: "memory")
#define PG8_BAR __builtin_amdgcn_s_barrier()
#define PG8_SCHED __builtin_amdgcn_sched_barrier(0)
    Unit cur, nxt; int ui = 0;
    if (!S.next(0, cur)) return;
    f32x4 acc[2][2][4][2];
#pragma unroll
    for (int a = 0; a < 2; ++a)
#pragma unroll
        for (int b = 0; b < 2; ++b)
#pragma unroll
            for (int m = 0; m < 4; ++m)
#pragma unroll
                for (int n = 0; n < 2; ++n) acc[a][b][m][n] = (f32x4){0.f, 0.f, 0.f, 0.f};
    bf16x8 At[4][2], B0[2][2], B1[2][2];
    const char* cA = (const char*)g.A + (size_t)cur.pm * tstepA + (size_t)cur.sub * g.a_sub_off; const char* cB = (const char*)g.Bt + (size_t)(cur.pn + cur.sub * g.b_sub_tiles) * tstepB;
    S.a_ready(cur);
    if constexpr (SP2) {
        PG8_STAGE(PG8_SB(0, 0), cB, voffB); PG8_STAGE(PG8_SB(0, 1), cB + hstepB, voffB); PG8_STAGE(PG8_SA(0, 0), cA, voffA); PG8_STAGE(PG8_SA(0, 1), cA + hstepA, voffA);
        if (wr == 1) PG8_BAR;
        PG8_WAIT_V(2); PG8_BAR;
        PG8_STAGE(PG8_SB(1, 0), cB + kstep, voffB); PG8_STAGE(PG8_SA(1, 0), cA + kstep, voffA); PG8_STAGE(PG8_SB(1, 1), cB + hstepB + kstep, voffB);
        PG8_WAIT_V(6); PG8_BAR;
    } else {
        PG8_STAGE(PG8_SB(0, 0), cB, voffB); PG8_STAGE(PG8_SA(0, 0), cA, voffA); PG8_STAGE(PG8_SB(0, 1), cB + hstepB, voffB); PG8_STAGE(PG8_SA(0, 1), cA + hstepA, voffA);
        if (wr == 1) PG8_BAR;
        PG8_WAIT_V(4); PG8_BAR;
        PG8_STAGE(PG8_SB(1, 0), cB + kstep, voffB); PG8_STAGE(PG8_SA(1, 0), cA + kstep, voffA); PG8_STAGE(PG8_SB(1, 1), cB + hstepB + kstep, voffB);
        PG8_WAIT_V(6); PG8_BAR;
    }
    for (;;) {
        const bool has_next = S.next(ui + 1, nxt);
        const char* nA = has_next ? (const char*)g.A + (size_t)nxt.pm * tstepA + (size_t)nxt.sub * g.a_sub_off : cA; const char* nB = has_next ? (const char*)g.Bt + (size_t)(nxt.pn + nxt.sub * g.b_sub_tiles) * tstepB : cB;
        for (int t = 0; t < nt; t += 2) {
            const bool last = (t == nt - 2);
            const char* a1 = cA + (size_t)(t + 1) * kstep;
            const char* a2 = last ? nA : cA + (size_t)(t + 2) * kstep; const char* b2 = last ? nB : cB + (size_t)(t + 2) * kstep;
            const char* a3 = a2 + kstep; const char* b3 = b2 + kstep;
            if (last && has_next) S.a_ready(nxt);
            if constexpr (SP2) {
            PG8_LDB(B0, 0, 0); PG8_LDB(B1, 0, 1); PG8_SCHED; PG8_LDA(At, 0, 0); PG8_STAGE(PG8_SA(1, 1), a1 + hstepA, voffA);
            PG8_WAIT_V(8); PG8_WAIT_L(0); PG8_BAR; PG8_MMA(0, 0, At, B0); PG8_MMA(0, 1, At, B1); PG8_BAR; PG8_SCHED;
            PG8_LDA(At, 0, 1); PG8_STAGE(PG8_SB(0, 0), b2, voffB); PG8_STAGE(PG8_SB(0, 1), b2 + hstepB, voffB); PG8_STAGE(PG8_SA(0, 0), a2, voffA);
            PG8_WAIT_V(8); PG8_WAIT_L(0); PG8_BAR; PG8_MMA(1, 0, At, B0); PG8_MMA(1, 1, At, B1); PG8_BAR; PG8_SCHED;
            PG8_LDB(B0, 1, 0); PG8_LDB(B1, 1, 1); PG8_SCHED; PG8_LDA(At, 1, 0); PG8_STAGE(PG8_SA(0, 1), a2 + hstepA, voffA);
            PG8_WAIT_V(8); PG8_WAIT_L(0); PG8_BAR; PG8_MMA(0, 0, At, B0); PG8_MMA(0, 1, At, B1); PG8_BAR; PG8_SCHED;
            PG8_LDA(At, 1, 1); PG8_STAGE(PG8_SB(1, 0), b3, voffB); PG8_STAGE(PG8_SB(1, 1), b3 + hstepB, voffB); PG8_STAGE(PG8_SA(1, 0), a3, voffA);
            PG8_WAIT_V(8); PG8_WAIT_L(0); PG8_BAR; PG8_MMA(1, 0, At, B0); PG8_MMA(1, 1, At, B1); PG8_BAR; PG8_SCHED;
            } else {
            PG8_LDB(B0, 0, 0); PG8_SCHED; PG8_LDA(At, 0, 0); PG8_STAGE(PG8_SA(1, 1), a1 + hstepA, voffA);
            PG8_WAIT_L(8); PG8_BAR; PG8_WAIT_L(0); PG8_MMA(0, 0, At, B0); PG8_BAR; PG8_SCHED;
            PG8_LDB(B1, 0, 1); PG8_STAGE(PG8_SB(0, 0), b2, voffB);
            PG8_BAR; PG8_WAIT_L(0); PG8_MMA(0, 1, At, B1); PG8_BAR;
            PG8_LDA(At, 0, 1); PG8_STAGE(PG8_SA(0, 0), a2, voffA);
            PG8_BAR; PG8_WAIT_L(0); PG8_MMA(1, 0, At, B0); PG8_BAR; PG8_SCHED;
            PG8_STAGE(PG8_SB(0, 1), b2 + hstepB, voffB);
            PG8_WAIT_V(6); PG8_BAR; PG8_MMA(1, 1, At, B1); PG8_BAR;
            PG8_LDB(B0, 1, 0); PG8_SCHED; PG8_LDA(At, 1, 0); PG8_STAGE(PG8_SA(0, 1), a2 + hstepA, voffA);
            PG8_WAIT_L(8); PG8_BAR; PG8_WAIT_L(0); PG8_MMA(0, 0, At, B0); PG8_BAR; PG8_SCHED;
            PG8_LDB(B1, 1, 1); PG8_STAGE(PG8_SB(1, 0), b3, voffB);
            PG8_BAR; PG8_WAIT_L(0); PG8_MMA(0, 1, At, B1); PG8_BAR;
            PG8_LDA(At, 1, 1); PG8_STAGE(PG8_SA(1, 0), a3, voffA);
            PG8_BAR; PG8_WAIT_L(0); PG8_MMA(1, 0, At, B0); PG8_BAR; PG8_SCHED;
            PG8_STAGE(PG8_SB(1, 1), b3 + hstepB, voffB);
            PG8_WAIT_V(6); PG8_BAR; PG8_MMA(1, 1, At, B1); PG8_BAR;
            }
        }
        if constexpr (ALIGN_EPI) { if (wr == 0) PG8_BAR; }
        if constexpr (!Epi::AFTER_DRAIN) { E(acc, cur, wr, wc, fr, fq); S.done(cur); }
        if (!has_next) break;
#pragma unroll
        for (int a = 0; a < 2; ++a)
#pragma unroll
            for (int b = 0; b < 2; ++b)
#pragma unroll
                for (int m = 0; m < 4; ++m)
#pragma unroll
                    for (int n = 0; n < 2; ++n) acc[a][b][m][n] = (f32x4){0.f, 0.f, 0.f, 0.f};
        cur = nxt; cA = nA; cB = nB; ++ui;
        if constexpr (ALIGN_EPI) { if (wr == 1) PG8_BAR; }
    }
    PG8_WAIT_V(0);
    if constexpr (!ALIGN_EPI) { if (wr == 0) PG8_BAR; }
    PG8_BAR;
    if constexpr (Epi::AFTER_DRAIN) { E.fused(acc, cur, wr, wc, fr, fq, lds, wid, lane); S.done(cur); }
#undef PG8_SA
#undef PG8_SB
#undef PG8_STAGE
#undef PG8_LDA
#undef PG8_LDB
#undef PG8_MMA
#undef PG8_WAIT_V
#undef PG8_WAIT_L
#undef PG8_BAR
#undef PG8_SCHED
}

}

struct Args { const float* in[17]; float* out; unsigned char* ws; };
struct Ctx {
    const float *xp, *xs, *ck, *cv, *g1, *w_in, *gs, *sgu_w, *sgu_b, *sinks, *w_oa, *w_ob, *w_out, *g2, *w_up, *w_down, *gf;
    float* out; unsigned char* ws;
    int G, bid;
};
#define MFMA16(a, b, c) __builtin_amdgcn_mfma_f32_16x16x32_bf16((a), (b), (c), 0, 0, 0)

__device__ __forceinline__ void p0_transpose_item(const float* W, int K, int N, bf16_t* WT, int row_off, const float* kscale, LAS float* scr, int item, int lane) {
    const int nblk = N / 32, kb = item / nblk, nb = item % nblk, k0 = 64 * kb, n0 = 32 * nb;
#pragma unroll 8
    for (int i = 0; i < 32; ++i) { const int kk = 2 * i + (lane >> 5); float v = W[(size_t)(k0 + kk) * N + n0 + (lane & 31)]; if (kscale) v *= kscale[k0 + kk]; scr[kk * 33 + (lane & 31)] = v; }
    asm volatile("s_waitcnt lgkmcnt(0)" ::: "memory");
    const int c = lane & 7;
#pragma unroll
    for (int j = 0; j < 4; ++j) { const int n = (lane >> 3) + 8 * j; const LAS float* s = scr + (8 * c) * 33 + n;
        u32x4 o; o.x = cvt_pk_bf16(s[0 * 33], s[1 * 33]); o.y = cvt_pk_bf16(s[2 * 33], s[3 * 33]); o.z = cvt_pk_bf16(s[4 * 33], s[5 * 33]); o.w = cvt_pk_bf16(s[6 * 33], s[7 * 33]);
        *(u32x4*)(WT + (size_t)(row_off + n0 + n) * K + k0 + 8 * c) = o; }
    asm volatile("s_waitcnt lgkmcnt(0)" ::: "memory");
}
__device__ __forceinline__ void rms_row_to_bf16(const float* xrow, const float* g, bf16_t* orow, int lane) {
    const f32x4* xr = (const f32x4*)xrow + lane; const f32x4* gr = (const f32x4*)g + lane;
    f32x4 v[4]; float s = 0.f;
#pragma unroll
    for (int j = 0; j < 4; ++j) { v[j] = xr[64 * j]; s += (v[j].x * v[j].x + v[j].y * v[j].y) + (v[j].z * v[j].z + v[j].w * v[j].w); }
    const float r = 1.0f / sqrtf(wave_sum(s) * (1.0f / D) + EPS);
    u32x2* o8 = (u32x2*)orow + lane;
#pragma unroll
    for (int j = 0; j < 4; ++j) { const f32x4 gg = gr[64 * j]; u32x2 w; w.x = cvt_pk_bf16(v[j].x * r * gg.x, v[j].y * r * gg.y); w.y = cvt_pk_bf16(v[j].z * r * gg.z, v[j].w * r * gg.w); o8[64 * j] = w; }
}
__device__ __forceinline__ void p0_prologue(const Ctx& F, LAS unsigned char* lds) {
    const int tid_ = opaque_tid(), lane_ = tid_ & 63, wave_ = __builtin_amdgcn_readfirstlane(tid_ >> 6);
    LAS float* scr = (LAS float*)(lds + wave_ * 16384);
    const int gw = F.bid * 8 + wave_, NGW = F.G * 8;
    constexpr int I_IN = (D / 64) * (INW / 32), I_D = (D / 64) * (D / 32), I_UP = (D / 64) * (FF / 32), I_DN = (FF / 64) * (D / 32);
    constexpr int NITEMS = I_IN + 3 * I_D + I_UP + I_DN;
    bf16_t* WinT = (bf16_t*)(F.ws + WS_WIN); bf16_t* WoabT = (bf16_t*)(F.ws + WS_WOAB); bf16_t* WoutT = (bf16_t*)(F.ws + WS_WOUT);
    bf16_t* WupT = (bf16_t*)(F.ws + WS_WUP); bf16_t* WdownT = (bf16_t*)(F.ws + WS_WDOWN);
    for (int it = gw; it < NITEMS; it += NGW) {
        int r = it;
        if (r < I_IN) { p0_transpose_item(F.w_in, D, INW, WinT, 0, nullptr, scr, r, lane_); continue; } r -= I_IN;
        if (r < I_D) { p0_transpose_item(F.w_oa, D, D, WoabT, 0, nullptr, scr, r, lane_); continue; } r -= I_D;
        if (r < I_D) { p0_transpose_item(F.w_ob, D, D, WoabT, D, nullptr, scr, r, lane_); continue; } r -= I_D;
        if (r < I_D) { p0_transpose_item(F.w_out, D, D, WoutT, 0, nullptr, scr, r, lane_); continue; } r -= I_D;
        if (r < I_UP) { p0_transpose_item(F.w_up, D, FF, WupT, 0, F.g2, scr, r, lane_); continue; } r -= I_UP;
        p0_transpose_item(F.w_down, FF, D, WdownT, 0, nullptr, scr, r, lane_);
    }
    bf16_t* XN = (bf16_t*)(F.ws + WS_XN); bf16_t* XNs = (bf16_t*)(F.ws + WS_XNS);
    for (int m = gw; m < MP + NS; m += NGW) {
        if (m < MP) rms_row_to_bf16(F.xp + (size_t)m * D, F.g1, XN + (size_t)m * D, lane_);
        else rms_row_to_bf16(F.xs + (size_t)(m - MP) * D, F.g1, XNs + (size_t)(m - MP) * D, lane_);
    }
    bf16_t* Wt = (bf16_t*)(F.ws + WS_WTRIL);
    for (int i = F.bid * 512 + tid_; i < 8 * 128 * 128; i += F.G * 512) { const int t = (i >> 7) & 127, s = i & 127; const float v = (s <= t) ? F.sgu_w[i] : 0.f; Wt[i] = (bf16_t)(cvt_pk_bf16(v, 0.f) & 0xffffu); }
}

__device__ __forceinline__ f32x4 skinny(const bf16_t* A, int lda, const bf16_t* Bt, int ldb, int K, int wave, int lane) {
    const int l15 = lane & 15, g = lane >> 4;
    const bf16_t* ap = A + (size_t)(16 * wave + l15) * lda + 8 * g; const bf16_t* bp = Bt + (size_t)l15 * ldb + 8 * g;
    f32x4 acc0 = {0.f, 0.f, 0.f, 0.f}, acc1 = {0.f, 0.f, 0.f, 0.f};
#pragma unroll 8
    for (int k = 0; k < K; k += 64) {
        const bf16x8 a0 = *(const bf16x8*)(ap + k), b0 = *(const bf16x8*)(bp + k), a1 = *(const bf16x8*)(ap + k + 32), b1 = *(const bf16x8*)(bp + k + 32);
        acc0 = MFMA16(b0, a0, acc0); acc1 = MFMA16(b1, a1, acc1);
    }
    return acc0 + acc1;
}
__device__ __forceinline__ float act_in(float v, int col) { return col < C_Q ? gelu_t(v) : (col < C_GA ? v : sigmoid_f(v)); }

constexpr int KP = 72;
__device__ __forceinline__ void attn_unit(const Ctx& F, LAS unsigned char* lds, bf16_t* H, int b, int kvh, int qb) {
    const int tid_ = opaque_tid(), lane_ = tid_ & 63, wave_ = __builtin_amdgcn_readfirstlane(tid_ >> 6);
    LAS bf16_t* Ks = (LAS bf16_t*)lds; LAS bf16_t* Vs = (LAS bf16_t*)(lds + 256 * KP * 2);
    const int tid = tid_, lane = lane_, l15 = lane & 15, g = lane >> 4, qt = wave_;
    const long rowbase = (long)b * SEQ + (long)(qb - 1) * 128;
#pragma unroll
    for (int i = 0; i < 4; ++i) { const int c = tid + 512 * i, j = c >> 3, ch = c & 7;
        u32x4 kv = {0u, 0u, 0u, 0u}, vv = {0u, 0u, 0u, 0u};
        if (qb > 0 || j >= 128) { const bf16_t* p = H + (size_t)(rowbase + j) * INW + C_K + kvh * 64 + ch * 8; kv = *(const u32x4*)p; vv = *(const u32x4*)(p + 256); }
        *(LAS u32x4*)(Ks + j * KP + ch * 8) = kv; *(LAS u32x4*)(Vs + j * KP + ch * 8) = vv; }
    if (tid < 128) *(LAS u32x4*)(Vs + (256 + (tid >> 3)) * KP + (tid & 7) * 8) = (u32x4){0u, 0u, 0u, 0u};
    __syncthreads();
    const int qq = l15 >> 2, pp = lane & 3;
    for (int hh = 0; hh < 4; ++hh) {
        const int h = kvh * 4 + hh; const float slope = __builtin_amdgcn_exp2f(-0.5f * (float)(h + 1)); const float sink = F.sinks[h];
        bf16_t* qp = H + (size_t)(b * SEQ + qb * 128 + 16 * qt + l15) * INW + C_Q + h * 64;
        const bf16x8 q0 = *(const bf16x8*)(qp + 8 * g), q1 = *(const bf16x8*)(qp + 8 * g + 32);
        f32x4 st[9];
#pragma unroll
        for (int kt = 0; kt < 9; ++kt) { const LAS bf16_t* kp = Ks + (16 * (qt + kt) + l15) * KP + 8 * g;
            const bf16x8 k0 = *(const LAS bf16x8*)kp, k1 = *(const LAS bf16x8*)(kp + 32);
            f32x4 z = {0.f, 0.f, 0.f, 0.f}; z = MFMA16(k0, q0, z); st[kt] = MFMA16(k1, q1, z); }
        float mx = sink;
#pragma unroll
        for (int kt = 0; kt < 9; ++kt)
#pragma unroll
            for (int i = 0; i < 4; ++i) { const int diff = 128 + l15 - 16 * kt - 4 * g - i; const int j = 16 * (qt + kt) + 4 * g + i;
                const bool valid = (diff >= 0) && (diff <= 128) && (qb > 0 || j >= 128);
                const float s = valid ? (st[kt][i] * 0.125f - slope * (float)diff) : -1e30f; st[kt][i] = s; mx = fmaxf(mx, s); }
        mx = fmaxf(mx, __shfl_xor(mx, 16)); mx = fmaxf(mx, __shfl_xor(mx, 32));
        float sum = 0.f;
#pragma unroll
        for (int kt = 0; kt < 9; ++kt)
#pragma unroll
            for (int i = 0; i < 4; ++i) { const float p = __builtin_amdgcn_exp2f((st[kt][i] - mx) * LOG2E); st[kt][i] = p; sum += p; }
        sum += __shfl_xor(sum, 16); sum += __shfl_xor(sum, 32);
        sum += __builtin_amdgcn_exp2f((sink - mx) * LOG2E);
        const float inv = 1.0f / sum;
        f32x4 o[4];
#pragma unroll
        for (int c = 0; c < 4; ++c) o[c] = (f32x4){0.f, 0.f, 0.f, 0.f};
#pragma unroll
        for (int ks = 0; ks < 5; ++ks) {
            u32x4 pw; pw.x = cvt_pk_bf16(st[2 * ks][0] * inv, st[2 * ks][1] * inv); pw.y = cvt_pk_bf16(st[2 * ks][2] * inv, st[2 * ks][3] * inv);
            if (ks < 4) { pw.z = cvt_pk_bf16(st[2 * ks + 1][0] * inv, st[2 * ks + 1][1] * inv); pw.w = cvt_pk_bf16(st[2 * ks + 1][2] * inv, st[2 * ks + 1][3] * inv); } else { pw.z = 0u; pw.w = 0u; }
            const bf16x8 pf = __builtin_bit_cast(bf16x8, pw);
            const LAS bf16_t* vb = Vs + (16 * (qt + 2 * ks) + 4 * g + qq) * KP + 4 * pp;
#pragma unroll
            for (int c = 0; c < 4; ++c) { const s16x4 lo = tr_read(vb + 16 * c), hi = tr_read(vb + 16 * KP + 16 * c);
                const bf16x8 vf = {lo[0], lo[1], lo[2], lo[3], hi[0], hi[1], hi[2], hi[3]};
                o[c] = MFMA16(vf, pf, o[c]); }
        }
#pragma unroll
        for (int c = 0; c < 4; ++c) { u32x2 w; w.x = cvt_pk_bf16(o[c][0], o[c][1]); w.y = cvt_pk_bf16(o[c][2], o[c][3]); *(u32x2*)(qp + 16 * c + 4 * g) = w; }
    }
    __syncthreads();
}

constexpr int VNP = 136;
__device__ __forceinline__ void sgu_unit(const Ctx& F, LAS unsigned char* lds, bf16_t* H, const float* vss, const bf16_t* Wt, int b, int ch_, int gi) {
    const int tid_ = opaque_tid(), lane_ = tid_ & 63, wave_ = __builtin_amdgcn_readfirstlane(tid_ >> 6);
    LAS bf16_t* VN = (LAS bf16_t*)lds; LAS float* rs = (LAS float*)(lds + 128 * VNP * 2);
    const int tid = tid_, lane = lane_, l15 = lane & 15, g = lane >> 4, tt = wave_;
    const size_t rowbase = (size_t)b * SEQ + (size_t)ch_ * 128;
    if (tid < 128) { const f32x4* sp = (const f32x4*)(vss + (rowbase + tid) * 16); const f32x4 s4 = (sp[0] + sp[1]) + (sp[2] + sp[3]);
        rs[tid] = 1.0f / sqrtf(((s4[0] + s4[1]) + (s4[2] + s4[3])) * (1.0f / D) + EPS); }
    __syncthreads();
    { const int cc = tid & 15; const f32x4 g0 = *(const f32x4*)(F.gs + gi * 128 + cc * 8), g1v = *(const f32x4*)(F.gs + gi * 128 + cc * 8 + 4);
#pragma unroll
      for (int i = 0; i < 4; ++i) { const int s = (tid >> 4) + 32 * i; const float r = rs[s];
          const u32x4 w = *(const u32x4*)(H + (rowbase + s) * INW + C_V + gi * 128 + cc * 8);
          u32x4 o; o.x = cvt_pk_bf16(bflo(w.x) * r * g0[0], bfhi(w.x) * r * g0[1]); o.y = cvt_pk_bf16(bflo(w.y) * r * g0[2], bfhi(w.y) * r * g0[3]);
          o.z = cvt_pk_bf16(bflo(w.z) * r * g1v[0], bfhi(w.z) * r * g1v[1]); o.w = cvt_pk_bf16(bflo(w.w) * r * g1v[2], bfhi(w.w) * r * g1v[3]);
          *(LAS u32x4*)(VN + s * VNP + cc * 8) = o; } }
    __syncthreads();
    const int nks = (tt >> 1) + 1; const int qq = l15 >> 2, pp = lane & 3;
    bf16x8 wf[4];
#pragma unroll
    for (int ks = 0; ks < 4; ++ks) wf[ks] = (ks < nks) ? *(const bf16x8*)(Wt + ((size_t)gi * 128 + 16 * tt + l15) * 128 + 32 * ks + 8 * g) : (bf16x8){0, 0, 0, 0, 0, 0, 0, 0};
    const float bias = F.sgu_b[gi * 128 + 16 * tt + l15];
    bf16_t* up = H + (rowbase + 16 * tt + l15) * INW + C_U + gi * 128 + 4 * g;
#pragma unroll
    for (int c = 0; c < 8; ++c) { f32x4 acc = {0.f, 0.f, 0.f, 0.f};
#pragma unroll
        for (int ks = 0; ks < 4; ++ks) if (ks < nks) { const LAS bf16_t* vb = VN + (32 * ks + 8 * g + qq) * VNP + 16 * c + 4 * pp;
            const s16x4 lo = tr_read(vb), hi = tr_read(vb + 4 * VNP);
            const bf16x8 vf = {lo[0], lo[1], lo[2], lo[3], hi[0], hi[1], hi[2], hi[3]};
            acc = MFMA16(vf, wf[ks], acc); }
        const u32x2 uw = *(const u32x2*)(up + 16 * c);
        u32x2 w; w.x = cvt_pk_bf16(bflo(uw.x) * (acc[0] + bias), bfhi(uw.x) * (acc[1] + bias)); w.y = cvt_pk_bf16(bflo(uw.y) * (acc[2] + bias), bfhi(uw.y) * (acc[3] + bias));
        *(u32x2*)(up + 16 * c) = w; }
    __syncthreads();
}

__device__ __forceinline__ void sample_row(const Ctx& F, LAS unsigned char* lds, int b) {
    const int tid_ = opaque_tid(), lane_ = tid_ & 63, wave_ = __builtin_amdgcn_readfirstlane(tid_ >> 6);
    LAS float* qs = (LAS float*)lds;
    LAS float* sc = qs + 1024;
    LAS float* red = sc + 16 * 132;
    const int tid = tid_, lane = lane_;
    const float* Hs = (const float*)(F.ws + WS_HS) + (size_t)b * INW; bf16_t* ABs = (bf16_t*)(F.ws + WS_ABS) + (size_t)b * 2048;
    const int d0 = tid * 2; const float gv0 = Hs[C_V + d0], gv1 = Hs[C_V + d0 + 1];
    float ss = wave_sum(gv0 * gv0 + gv1 * gv1); if (lane == 0) red[wave_] = ss;
    qs[tid] = Hs[C_Q + tid]; qs[tid + 512] = Hs[C_Q + tid + 512];
    __syncthreads();
    { float tot = 0.f;
#pragma unroll
      for (int w = 0; w < 8; ++w) tot += red[w];
      const float r = 1.0f / sqrtf(tot * (1.0f / D) + EPS); const int gi = d0 >> 7;
      const float vn0 = gv0 * r * F.gs[d0], vn1 = gv1 * r * F.gs[d0 + 1];
      F.out[O_SGV + (size_t)b * D + d0] = vn0; F.out[O_SGV + (size_t)b * D + d0 + 1] = vn1;
      const float w00 = F.sgu_w[gi * 16384], b0 = F.sgu_b[gi * 128];
      *(unsigned*)(ABs + d0) = cvt_pk_bf16(Hs[C_U + d0] * (w00 * vn0 + b0), Hs[C_U + d0 + 1] * (w00 * vn1 + b0)); }
    const int h = tid >> 5, jj = tid & 31, kvh = h >> 2; const float slope = __builtin_amdgcn_exp2f(-0.5f * (float)(h + 1)); const float sink = F.sinks[h];
    const LAS f32x4* q4 = (const LAS f32x4*)(qs + h * 64);
    float sv[5]; float mx = sink;
#pragma unroll
    for (int r = 0; r < 4; ++r) { const int j = jj + 32 * r; const f32x4* kp = (const f32x4*)(F.ck + ((size_t)(b * 128 + j) * 4 + kvh) * 64); float dot = 0.f;
#pragma unroll
        for (int e = 0; e < 16; ++e) { const f32x4 kk = kp[e], q = q4[e]; dot += (kk.x * q.x + kk.y * q.y) + (kk.z * q.z + kk.w * q.w); }
        sv[r] = dot * 0.125f - slope * (float)(128 - j); mx = fmaxf(mx, sv[r]); }
    { const f32x4* kp = (const f32x4*)(Hs + C_K + kvh * 64); float dot = 0.f;
#pragma unroll
      for (int e = 0; e < 16; ++e) { const f32x4 kk = kp[e], q = q4[e]; dot += (kk.x * q.x + kk.y * q.y) + (kk.z * q.z + kk.w * q.w); }
      sv[4] = (jj == 0) ? dot * 0.125f : -1e30f; mx = fmaxf(mx, sv[4]); }
#pragma unroll
    for (int o = 1; o < 32; o <<= 1) mx = fmaxf(mx, __shfl_xor(mx, o));
    float sum = 0.f;
#pragma unroll
    for (int r = 0; r < 5; ++r) { sv[r] = __builtin_amdgcn_exp2f((sv[r] - mx) * LOG2E); sum += sv[r]; }
#pragma unroll
    for (int o = 1; o < 32; o <<= 1) sum += __shfl_xor(sum, o);
    sum += __builtin_amdgcn_exp2f((sink - mx) * LOG2E);
    const float inv = 1.0f / sum;
#pragma unroll
    for (int r = 0; r < 4; ++r) sc[h * 132 + jj + 32 * r] = sv[r] * inv;
    if (jj == 0) sc[h * 132 + 128] = sv[4] * inv;
    __syncthreads();
    { const int d2 = jj * 2; float o0 = 0.f, o1 = 0.f; const float* vp = F.cv + ((size_t)b * 128 * 4 + kvh) * 64 + d2;
#pragma unroll 8
      for (int j = 0; j < 128; ++j) { const float p = sc[h * 132 + j]; const f32x2 v = *(const f32x2*)(vp + (size_t)j * 256); o0 += p * v.x; o1 += p * v.y; }
      const float p = sc[h * 132 + 128]; o0 += p * Hs[C_VA + kvh * 64 + d2]; o1 += p * Hs[C_VA + kvh * 64 + d2 + 1];
      *(unsigned*)(ABs + 1024 + h * 64 + d2) = cvt_pk_bf16(o0, o1); }
    __syncthreads();
}

#define XB_TMO      128
#define XB_XCNT(j)  (256  + 64 * (j))
#define XB_XSUB(j)  (1280 + 64 * (j))
#define XB_XGEN(j)  (2304 + 64 * (j))
#define XB_TOP      3328
#define XB_TOPGEN   3392
#define XCD_BAR_WORDS 3456
#define XB_SPIN_CAP (1u << 18)
__device__ __forceinline__ unsigned xb_ld(unsigned* p)              { return __hip_atomic_load(p, __ATOMIC_RELAXED, __HIP_MEMORY_SCOPE_AGENT); }
__device__ __forceinline__ unsigned xb_add(unsigned* p, unsigned v) { return __hip_atomic_fetch_add(p, v, __ATOMIC_RELAXED, __HIP_MEMORY_SCOPE_AGENT); }
__device__ __forceinline__ unsigned xb_xcc_id() { return (unsigned)__builtin_amdgcn_s_getreg((3 << 11) | 20) & 0xFu; }
#define XB_SPIN(cond, bar) do { unsigned _sp = 0; while (cond) { __builtin_amdgcn_s_sleep(1); \
    if ((++_sp & 255u) == 0u) { if (xb_ld(&(bar)[XB_TMO])) break; if (_sp > XB_SPIN_CAP) { atomicAdd(&(bar)[XB_TMO], 1u); break; } } } } while (0)
struct XcdBarrier { unsigned* bar; unsigned x; volatile LAS unsigned* st; };
__device__ __forceinline__ XcdBarrier xcd_barrier_post(unsigned* bar, volatile LAS unsigned* st) {
    XcdBarrier b; b.bar = bar; b.x = xb_xcc_id(); b.st = st;
    if (threadIdx.x == 0) (void)xb_add(&bar[XB_XCNT(b.x)], 1u);
    return b;
}
__device__ __forceinline__ void xcd_barrier_complete(unsigned* bar, unsigned x, unsigned& nloc, unsigned& nx) {
    const unsigned G = gridDim.x * gridDim.y * gridDim.z;
    unsigned sum, cnt, mine, sp = 0u;
    for (;;) {
        sum = 0u; cnt = 0u; mine = 0u;
#pragma unroll
        for (unsigned j = 0; j < 16; ++j) { const unsigned c = xb_ld(&bar[XB_XCNT(j)]); sum += c; cnt += (c > 0u) ? 1u : 0u; mine = (j == x) ? c : mine; }
        if (sum == G) break;
        __builtin_amdgcn_s_sleep(1);
        if ((++sp & 255u) == 0u) { if (xb_ld(&bar[XB_TMO])) break; if (sp > XB_SPIN_CAP) { atomicAdd(&bar[XB_TMO], 1u); break; } }
    }
    nloc = mine > 0u ? mine : 1u; nx = cnt > 0u ? cnt : 1u;
}
__device__ __forceinline__ void xcd_barrier(const XcdBarrier& b) {
    asm volatile("s_waitcnt vmcnt(0)" ::: "memory");
    __syncthreads();
    if (threadIdx.x == 0) {
        unsigned* bar = b.bar;
        __builtin_amdgcn_s_waitcnt(0);
        unsigned nloc = b.st[0], nx = b.st[1];
        if (nloc == 0u) { xcd_barrier_complete(bar, b.x, nloc, nx); b.st[0] = nloc; b.st[1] = nx; }
        const unsigned old = xb_add(&bar[XB_XSUB(b.x)], 1u);
        const unsigned gen = old / nloc;
        if (old + 1u == (gen + 1u) * nloc) {
            __builtin_amdgcn_fence(__ATOMIC_RELEASE, "agent");
            asm volatile("s_waitcnt vmcnt(0)" ::: "memory");
            const unsigned og = xb_add(&bar[XB_TOP], 1u);
            const unsigned tg = og / nx;
            if (og + 1u == (tg + 1u) * nx) xb_add(&bar[XB_TOPGEN], 1u);
            else XB_SPIN(xb_ld(&bar[XB_TOPGEN]) == tg, bar);
            __builtin_amdgcn_fence(__ATOMIC_ACQUIRE, "agent");
            xb_add(&bar[XB_XGEN(b.x)], 1u);
            asm volatile("s_waitcnt vmcnt(0)" ::: "memory");
        } else {
            XB_SPIN(xb_ld(&bar[XB_XGEN(b.x)]) == gen, bar);
            __builtin_amdgcn_fence(__ATOMIC_ACQUIRE, "agent");
            asm volatile("s_waitcnt vmcnt(0)" ::: "memory");
        }
    }
    __syncthreads();
}

#define PHASE_IDS const int tid_ = opaque_tid(), lane = tid_ & 63, wave = __builtin_amdgcn_readfirstlane(tid_ >> 6), l15 = lane & 15, g4 = lane >> 4; (void)l15; (void)g4; (void)wave;
__global__ void __launch_bounds__(512, 2) fwd_megakernel(Args args) {
    extern __shared__ __attribute__((aligned(16))) unsigned char lds_raw[];
    LAS unsigned char* lds = (LAS unsigned char*)lds_raw;
    cg::grid_group grid = cg::this_grid();
    Ctx F;
    F.xp = args.in[0]; F.xs = args.in[1]; F.ck = args.in[2]; F.cv = args.in[3]; F.g1 = args.in[4]; F.w_in = args.in[5]; F.gs = args.in[6]; F.sgu_w = args.in[7];
    F.sgu_b = args.in[8]; F.sinks = args.in[9]; F.w_oa = args.in[10]; F.w_ob = args.in[11]; F.w_out = args.in[12]; F.g2 = args.in[13]; F.w_up = args.in[14];
    F.w_down = args.in[15]; F.gf = args.in[16]; F.out = args.out; F.ws = args.ws;
    F.G = gridDim.x; F.bid = blockIdx.x;
    unsigned char* ws = args.ws;
    float* vss = (float*)(ws + WS_VSS); float* x1ss = (float*)(ws + WS_X1SS);
    bf16_t* H = (bf16_t*)(ws + WS_H); bf16_t* XN = (bf16_t*)(ws + WS_XN); bf16_t* T1 = (bf16_t*)(ws + WS_T1); bf16_t* X1B = (bf16_t*)(ws + WS_X1B); bf16_t* Fb = (bf16_t*)(ws + WS_F);
    bf16_t* WinT = (bf16_t*)(ws + WS_WIN); bf16_t* WoabT = (bf16_t*)(ws + WS_WOAB); bf16_t* WoutT = (bf16_t*)(ws + WS_WOUT); bf16_t* WupT = (bf16_t*)(ws + WS_WUP); bf16_t* WdownT = (bf16_t*)(ws + WS_WDOWN);
    bf16_t* XNs = (bf16_t*)(ws + WS_XNS); float* Hs = (float*)(ws + WS_HS); bf16_t* ABs = (bf16_t*)(ws + WS_ABS); bf16_t* Hgs = (bf16_t*)(ws + WS_HGS);
    float* X1s = (float*)(ws + WS_X1S); bf16_t* X1Bs = (bf16_t*)(ws + WS_X1BS); bf16_t* Fs = (bf16_t*)(ws + WS_FS); float* Ds = (float*)(ws + WS_DS);
    const bf16_t* Wt = (const bf16_t*)(ws + WS_WTRIL);
    float* y = F.out + O_YP;

    unsigned* barw = (unsigned*)(ws + WS_BAR);
    if (threadIdx.x < 4) ((LAS unsigned*)(lds + 131072 + 128))[threadIdx.x] = 0u;
    if (blockIdx.x == 0) for (int i = threadIdx.x; i < XCD_BAR_WORDS; i += 512) __hip_atomic_store(barw + i, 0u, __ATOMIC_RELAXED, __HIP_MEMORY_SCOPE_AGENT);
    __syncthreads();
    p0_prologue(F, lds);
    grid.sync();
    const XcdBarrier xb = xcd_barrier_post(barw, (volatile LAS unsigned*)(lds + 131072 + 128));

    { PHASE_IDS
    for (int it = F.bid; it < INW / 16; it += F.G) { const int n0 = it * 16;
        const f32x4 acc = skinny(XNs, D, WinT + (size_t)n0 * D, D, D, wave, lane);
        const int row = 16 * wave + l15, col = n0 + 4 * g4; f32x4 o;
#pragma unroll
        for (int i = 0; i < 4; ++i) o[i] = act_in(acc[i], col);
        *(f32x4*)(Hs + (size_t)row * INW + col) = o; } }
    __syncthreads();
    { pg8::Gemm g{XN, WinT, D, D, 0, 0}; pg8::StaticOrder S; S.init(MP, INW, F.G, F.bid, 1); pg8::EpiIn E{H, vss};
      pg8::gemm_phase<pg8::EpiIn, pg8::StaticOrder, true, true>(lds, g, S, E); }
    xcd_barrier(xb);

    { PHASE_IDS const int gt = F.bid * 512 + tid_, GT = F.G * 512;
      for (int idx = gt; idx < 128 * 128 * 64; idx += GT) { const int b = idx >> 13, w = (idx >> 6) & 127, c4 = idx & 63;
          f32x4 kv, vv;
          if (w < 127) { kv = *(const f32x4*)(F.ck + ((size_t)(b * 128 + w + 1) * 256 + c4 * 4)); vv = *(const f32x4*)(F.cv + ((size_t)(b * 128 + w + 1) * 256 + c4 * 4)); }
          else { kv = *(const f32x4*)(Hs + (size_t)b * INW + C_K + c4 * 4); vv = *(const f32x4*)(Hs + (size_t)b * INW + C_VA + c4 * 4); }
          *(f32x4*)(F.out + O_KWS + (size_t)idx * 4) = kv; *(f32x4*)(F.out + O_VWS + (size_t)idx * 4) = vv; }
      for (int idx = gt; idx < 4 * 128 * 64; idx += GT) { const int b = idx >> 13, w = (idx >> 6) & 127, c8 = idx & 63;
          const u32x4 wv = *(const u32x4*)(H + (size_t)(b * SEQ + SEQ - 128 + w) * INW + C_K + c8 * 8);
          float* op = F.out + (c8 < 32 ? O_KWP : O_VWP) + (size_t)(b * 128 + w) * 256 + (c8 & 31) * 8;
          *(f32x4*)op = (f32x4){bflo(wv.x), bfhi(wv.x), bflo(wv.y), bfhi(wv.y)}; *(f32x4*)(op + 4) = (f32x4){bflo(wv.z), bfhi(wv.z), bflo(wv.w), bfhi(wv.w)}; }
    }
    for (int it = F.bid; it < 512 + 1024 + 128; it += F.G) {
        if (it < 512) { const int qb = it & 31, kvh = (it >> 5) & 3, b = it >> 7; attn_unit(F, lds, H, b, kvh, qb); }
        else if (it < 1536) { const int r = it - 512; const int gi = r & 7, ch = (r >> 3) & 31, b = r >> 8; sgu_unit(F, lds, H, vss, Wt, b, ch, gi); }
        else sample_row(F, lds, it - 1536);
    }
    xcd_barrier(xb);

    { PHASE_IDS
    for (int it = F.bid; it < D / 16; it += F.G) { const int n0 = it * 16;
        const f32x4 accA = skinny(ABs, 2048, WoabT + (size_t)n0 * D, D, D, wave, lane);
        const f32x4 accB = skinny(ABs + 1024, 2048, WoabT + (size_t)(1024 + n0) * D, D, D, wave, lane);
        const int row = 16 * wave + l15, col = n0 + 4 * g4;
        const f32x4 ga = *(const f32x4*)(Hs + (size_t)row * INW + C_GA + col), gb = *(const f32x4*)(Hs + (size_t)row * INW + C_GB + col);
        const f32x4 hv = ga * accA + gb * accB; u32x2 w; w.x = cvt_pk_bf16(hv[0], hv[1]); w.y = cvt_pk_bf16(hv[2], hv[3]);
        *(u32x2*)(Hgs + (size_t)row * D + col) = w; } }
    __syncthreads();
    { pg8::Gemm g{H + C_U, WoabT, INW, D, (size_t)(C_Q - C_U) * 2, 4}; pg8::StaticOrder S; S.init(MP, D, F.G, F.bid, 2); pg8::EpiOab E{H, T1};
      pg8::gemm_phase<pg8::EpiOab, pg8::StaticOrder, true, true>(lds, g, S, E); }
    xcd_barrier(xb);

    { PHASE_IDS
    for (int it = F.bid; it < D / 16; it += F.G) { const int n0 = it * 16;
        const f32x4 acc = skinny(Hgs, D, WoutT + (size_t)n0 * D, D, D, wave, lane);
        const int row = 16 * wave + l15, col = n0 + 4 * g4;
        const f32x4 v = acc + *(const f32x4*)(F.xs + (size_t)row * D + col);
        *(f32x4*)(X1s + (size_t)row * D + col) = v; u32x2 w; w.x = cvt_pk_bf16(v[0], v[1]); w.y = cvt_pk_bf16(v[2], v[3]); *(u32x2*)(X1Bs + (size_t)row * D + col) = w; } }
    __syncthreads();
    { pg8::Gemm g{T1, WoutT, D, D, 0, 0}; pg8::StaticOrder S; S.init(MP, D, F.G, F.bid, 1); pg8::EpiOut E{F.xp, y, X1B, x1ss};
      pg8::gemm_phase<pg8::EpiOut, pg8::StaticOrder, true, true>(lds, g, S, E); }
    xcd_barrier(xb);

    { PHASE_IDS
    for (int it = F.bid; it < FF / 16; it += F.G) { const int n0 = it * 16;
        const f32x4 acc = skinny(X1Bs, D, WupT + (size_t)n0 * D, D, D, wave, lane);
        const int row = 16 * wave + l15, col = n0 + 4 * g4; f32x4 v;
#pragma unroll
        for (int i = 0; i < 4; ++i) { const float a = fmaxf(acc[i], 0.f); v[i] = a * a; }
        u32x2 w; w.x = cvt_pk_bf16(v[0], v[1]); w.y = cvt_pk_bf16(v[2], v[3]); *(u32x2*)(Fs + (size_t)row * FF + col) = w; } }
    __syncthreads();
    { pg8::Gemm g{X1B, WupT, D, D, 0, 0}; pg8::StaticOrder S; S.init(MP, FF, F.G, F.bid, 1); pg8::EpiUp E{Fb};
      pg8::gemm_phase<pg8::EpiUp, pg8::StaticOrder, true, true>(lds, g, S, E); }
    xcd_barrier(xb);

    { PHASE_IDS
    for (int it = F.bid; it < 256; it += F.G) { const int n0 = (it & 63) * 16, ks = it >> 6;
        const f32x4 acc = skinny(Fs + ks * 1024, FF, WdownT + (size_t)n0 * FF + ks * 1024, FF, 1024, wave, lane);
        const int row = 16 * wave + l15, col = n0 + 4 * g4;
        *(f32x4*)(Ds + ((size_t)ks * NS + row) * D + col) = acc; } }
    __syncthreads();
    { pg8::Gemm g{Fb, WdownT, FF, FF, 0, 0}; pg8::StaticOrder S; S.init(MP, D, F.G, F.bid, 1); pg8::EpiDown E{y, x1ss};
      pg8::gemm_phase<pg8::EpiDown, pg8::StaticOrder, true, true>(lds, g, S, E); }
    xcd_barrier(xb);

    { PHASE_IDS const int gw = F.bid * 8 + wave, NGW = F.G * 8;
      for (int m = gw; m < MP + NS; m += NGW) {
          f32x4 v[4]; const f32x4* gr = (const f32x4*)F.gf + lane; float* orow;
          if (m < MP) { orow = y + (size_t)m * D; const f32x4* xr = (const f32x4*)orow + lane;
#pragma unroll
              for (int j = 0; j < 4; ++j) v[j] = xr[64 * j];
          } else { const int r = m - MP; orow = F.out + O_YS + (size_t)r * D; const f32x4* xr = (const f32x4*)(X1s + (size_t)r * D) + lane; float s1 = 0.f;
#pragma unroll
              for (int j = 0; j < 4; ++j) { v[j] = xr[64 * j]; s1 += (v[j].x * v[j].x + v[j].y * v[j].y) + (v[j].z * v[j].z + v[j].w * v[j].w); }
              const float r2 = 1.0f / (wave_sum(s1) * (1.0f / D) + EPS);
#pragma unroll
              for (int j = 0; j < 4; ++j) { f32x4 d = {0.f, 0.f, 0.f, 0.f};
#pragma unroll
                  for (int ks = 0; ks < 4; ++ks) d += ((const f32x4*)(Ds + ((size_t)ks * NS + r) * D) + lane)[64 * j];
                  v[j] += d * r2; }
          }
          float s = 0.f;
#pragma unroll
          for (int j = 0; j < 4; ++j) s += (v[j].x * v[j].x + v[j].y * v[j].y) + (v[j].z * v[j].z + v[j].w * v[j].w);
          const float rr = 1.0f / sqrtf(wave_sum(s) * (1.0f / D) + EPS);
#pragma unroll
          for (int j = 0; j < 4; ++j) ((f32x4*)orow + lane)[64 * j] = v[j] * rr * gr[64 * j];
      }
    }
}

extern "C" void kernel_launch(void* const* d_in, const int* in_sizes, int n_in, void* d_out, int out_size, void* d_ws, size_t ws_size, hipStream_t stream) {
    static int grid = 0;
    if (grid == 0) {
        if (n_in != 17 || in_sizes[0] != MP * D || (size_t)out_size != O_END || ws_size < WS_END) {
            fprintf(stderr, "kernel_launch: unexpected shapes: n_in %d in0 %d out %d ws %zu\n", n_in, n_in > 0 ? in_sizes[0] : -1, out_size, ws_size); grid = -1; return; }
        int dev = 0, cus = 0, per_cu = 0;
        hipGetDevice(&dev); hipDeviceGetAttribute(&cus, hipDeviceAttributeMultiprocessorCount, dev);
        if (hipFuncSetAttribute((const void*)fwd_megakernel, hipFuncAttributeMaxDynamicSharedMemorySize, LDS_BYTES) != hipSuccess) { fprintf(stderr, "kernel_launch: hipFuncSetAttribute failed\n"); grid = -1; return; }
        if (hipOccupancyMaxActiveBlocksPerMultiprocessor(&per_cu, (const void*)fwd_megakernel, 512, LDS_BYTES) != hipSuccess || per_cu < 1) { fprintf(stderr, "kernel_launch: occupancy query gave %d\n", per_cu); per_cu = 1; }
        (void)hipGetLastError();
        grid = cus * 1;
        if (grid > 256) grid = 256;
    }
    if (grid < 0) return;
    Args a{};
    for (int i = 0; i < 17; ++i) a.in[i] = (const float*)d_in[i];
    a.out = (float*)d_out; a.ws = (unsigned char*)d_ws;
    void* kargs[] = {&a};
    hipError_t e = hipLaunchCooperativeKernel((const void*)fwd_megakernel, dim3(grid), dim3(512), kargs, LDS_BYTES, stream);
    if (e != hipSuccess) fprintf(stderr, "kernel_launch: cooperative launch failed: %s (grid %d)\n", hipGetErrorString(e), grid);
}
```

```cpp
#include <hip/hip_runtime.h>
#include <hip/hip_cooperative_groups.h>
#include <cstdio>
#include <cstdint>
namespace cg = cooperative_groups;

#define LAS __attribute__((address_space(3)))
#define PG8_LAS __attribute__((address_space(3)))
typedef unsigned short bf16_t;
typedef short bf16x8 __attribute__((ext_vector_type(8)));
typedef short s16x4 __attribute__((ext_vector_type(4)));
typedef float f32x4 __attribute__((ext_vector_type(4)));
typedef float f32x2 __attribute__((ext_vector_type(2)));
typedef unsigned u32x4 __attribute__((ext_vector_type(4)));
typedef unsigned u32x2 __attribute__((ext_vector_type(2)));

constexpr int D = 1024, SEQ = 4096, NBATCH = 4, MP = NBATCH * SEQ, NS = 128, INW = 5632, FF = 4096;
constexpr int C_U = 0, C_V = 1024, C_Q = 2048, C_K = 3072, C_VA = 3328, C_GA = 3584, C_GB = 4608;
constexpr float EPS = 1e-6f;
constexpr float LOG2E = 1.4426950408889634f;
constexpr size_t O_YP = 0, O_YS = (size_t)MP * D, O_KWP = O_YS + (size_t)NS * D, O_VWP = O_KWP + 131072, O_KWS = O_VWP + 131072,
                 O_VWS = O_KWS + 4194304, O_SGV = O_VWS + 4194304, O_END = O_SGV + 131072;
constexpr size_t KiB = 1024, MiB = 1024 * 1024;
constexpr size_t WS_VSS = 0, WS_X1SS = 1 * MiB;
constexpr size_t WS_XNS = 2 * MiB, WS_HS = WS_XNS + 256 * KiB, WS_ABS = 5 * MiB, WS_HGS = WS_ABS + 512 * KiB, WS_X1S = WS_HGS + 256 * KiB,
                 WS_X1BS = WS_X1S + 512 * KiB, WS_FS = WS_X1BS + 256 * KiB, WS_DS = WS_FS + 1 * MiB, WS_WTRIL = WS_DS + 2 * MiB;
constexpr size_t WS_WIN = 10 * MiB, WS_WOAB = 21 * MiB, WS_WOUT = 25 * MiB, WS_WUP = 27 * MiB, WS_WDOWN = 35 * MiB;
constexpr size_t WS_H = 44 * MiB, WS_X1B = WS_H, WS_F = WS_H + 32 * MiB, WS_XN = 220 * MiB, WS_T1 = WS_XN, WS_END = 252 * MiB;
static_assert(WS_HS + (size_t)NS * INW * 4 <= WS_ABS && WS_WTRIL + 256 * KiB <= WS_WIN && WS_WIN + (size_t)INW * D * 2 <= WS_WOAB, "ws map");
static_assert(WS_H + (size_t)MP * INW * 2 <= WS_XN && WS_F + (size_t)MP * FF * 2 <= WS_XN, "ws map 2");
constexpr size_t WS_BAR = WS_WTRIL + 256 * KiB;
static_assert(WS_BAR + 16384 <= WS_WIN, "ws map 3");
constexpr int LDS_BYTES = 147456;

__device__ __forceinline__ unsigned cvt_pk_bf16(float lo, float hi) { unsigned r; asm volatile("v_cvt_pk_bf16_f32 %0, %1, %2" : "=v"(r) : "v"(lo), "v"(hi)); return r; }
__device__ __forceinline__ float bflo(unsigned w) { return __uint_as_float(w << 16); }
__device__ __forceinline__ float bfhi(unsigned w) { return __uint_as_float(w & 0xffff0000u); }
__device__ __forceinline__ float bf1(bf16_t h) { return __uint_as_float(((unsigned)h) << 16); }
__device__ __forceinline__ float gelu_t(float x) {
    const float u = x * (1.0f + 0.044715f * x * x);
    const float e = __builtin_amdgcn_exp2f(-2.302208198f * u);
    return x * __builtin_amdgcn_rcpf(1.0f + e);
}
__device__ __forceinline__ float sigmoid_f(float x) { return __builtin_amdgcn_rcpf(1.0f + __builtin_amdgcn_exp2f(-LOG2E * x)); }
__device__ __forceinline__ int opaque_tid() { int t = threadIdx.x; asm volatile("" : "+v"(t)); return t; }
__device__ __forceinline__ float wave_sum(float v) {
#pragma unroll
    for (int o = 1; o < 64; o <<= 1) v += __shfl_xor(v, o);
    return v;
}
__device__ __forceinline__ s16x4 tr_read(const LAS bf16_t* p) {
    typedef short v4i16_t __attribute__((ext_vector_type(4)));
    return __builtin_bit_cast(s16x4, __builtin_amdgcn_ds_read_tr16_b64_v4i16((LAS v4i16_t*)p));
}

namespace pg8 {
constexpr int BM = 256, BK = 64, HALF = 128, HTB = HALF * BK * 2, STAGE_BYTES = 8 * HTB, NXCD = 8, WGM = 8;
__host__ __device__ __forceinline__ int lds_byte(int r, int c) { const int st = (r >> 4) * 2 + (c >> 5), rr = r & 15, cc = c & 31, ob = rr * 64 + cc * 2; return st * 1024 + (ob ^ (((ob >> 9) & 1) << 5)); }
__host__ __device__ __forceinline__ void stage_rc(int b, int& R, int& C) { const int st = b / 1024, sb = b % 1024, swz = sb ^ (((sb >> 9) & 1) << 5); R = (st >> 1) * 16 + swz / 64; C = (st & 1) * 32 + (swz % 64) / 2; }
__host__ __device__ __forceinline__ int perm32(int rho) { const int n = rho >> 4, i = rho & 15; return 8 * (i >> 2) + 4 * n + (i & 3); }

struct Unit { int pm, pn, sub; };
struct Gemm { const bf16_t* A; const bf16_t* Bt; int lda, K; size_t a_sub_off; int b_sub_tiles; };

struct StaticOrder {
    int nM, nN, nwg, G, c, nsub;
    __host__ __device__ void init(int M, int N, int G_, int c_, int nsub_) { nM = M / BM; nN = N / BM; nwg = nM * nN; G = G_; c = c_; nsub = nsub_; }
    __host__ __device__ bool next(int i, Unit& u) const {
        const int j = i / nsub; u.sub = i - j * nsub;
        const long L = (long)j * G + c; if (L >= nwg) return false;
        int wgid = (int)L; { const int q = nwg / NXCD, r = nwg % NXCD, xcd = wgid % NXCD, off = wgid / NXCD; wgid = (xcd < r ? xcd * (q + 1) : r * (q + 1) + (xcd - r) * q) + off; }
        const int nig = WGM * nN, gid = wgid / nig, fm = gid * WGM, gsz = (nM - fm) < WGM ? (nM - fm) : WGM;
        u.pm = fm + ((wgid % nig) % gsz); u.pn = (wgid % nig) / gsz; return true;
    }
    __device__ __forceinline__ void a_ready(const Unit&) const {}
    __device__ __forceinline__ void done(const Unit&) const {}
};

__device__ __forceinline__ u32x4 pack8(const f32x4 v0, const f32x4 v1) { u32x4 w; w.x = cvt_pk_bf16(v0[0], v0[1]); w.y = cvt_pk_bf16(v0[2], v0[3]); w.z = cvt_pk_bf16(v1[0], v1[1]); w.w = cvt_pk_bf16(v1[2], v1[3]); return w; }

struct EpiIn {
    static constexpr bool PERM = true, AFTER_DRAIN = false, HAS_INIT = false;
    bf16_t* H; float* vss;
    __device__ __forceinline__ void operator()(const f32x4 (&acc)[2][2][4][2], const Unit& u, int wr, int wc, int fr, int fq) const {
        const int pn = u.pn; const int mode = pn < 8 ? 1 : (pn < 14 ? 0 : 2); const bool isv = (pn >= 4 && pn < 8);
        const int row0 = u.pm * BM + wr * 64 + fr, col0 = pn * BM + wc * 32 + 8 * fq;
#pragma unroll
        for (int ai = 0; ai < 2; ++ai)
#pragma unroll
            for (int m = 0; m < 4; ++m) { const int row = row0 + ai * HALF + m * 16; bf16_t* rowp = H + (size_t)row * INW + col0; float ss = 0.f;
#pragma unroll
                for (int bj = 0; bj < 2; ++bj) { f32x4 v0 = acc[ai][bj][m][0], v1 = acc[ai][bj][m][1];
                    if (mode == 1) {
#pragma unroll
                        for (int e = 0; e < 4; ++e) { v0[e] = gelu_t(v0[e]); v1[e] = gelu_t(v1[e]); }
                        if (isv) {
#pragma unroll
                            for (int e = 0; e < 4; ++e) ss += v0[e] * v0[e] + v1[e] * v1[e]; }
                    } else if (mode == 2) {
#pragma unroll
                        for (int e = 0; e < 4; ++e) { v0[e] = sigmoid_f(v0[e]); v1[e] = sigmoid_f(v1[e]); }
                    }
                    *(u32x4*)(rowp + bj * HALF) = pack8(v0, v1); }
                if (isv) { ss += __shfl_xor(ss, 16); ss += __shfl_xor(ss, 32); if (fq == 0) vss[(size_t)row * 16 + (pn - 4) * 4 + wc] = ss; }
            }
    }
};
struct EpiOab {
    static constexpr bool PERM = true, AFTER_DRAIN = false, HAS_INIT = false;
    const bf16_t* __restrict__ H; bf16_t* __restrict__ T1;
    __device__ __forceinline__ void operator()(const f32x4 (&acc)[2][2][4][2], const Unit& u, int wr, int wc, int fr, int fq) const {
        const int row0 = u.pm * BM + wr * 64 + fr, col0 = u.pn * BM + wc * 32 + 8 * fq; const int gcol = C_GA + u.sub * 1024 + col0; const bool second = u.sub != 0;
#pragma unroll
        for (int aim = 0; aim < 4; ++aim) { const int ai = aim >> 1, mb = (aim & 1) * 2;
            u32x4 gw[4][2], tw[4][2];
#pragma unroll
            for (int m = mb; m < mb + 2; ++m)
#pragma unroll
                for (int bj = 0; bj < 2; ++bj) { const int row = row0 + ai * HALF + m * 16;
                    gw[m][bj] = *(const u32x4*)(H + (size_t)row * INW + gcol + bj * HALF);
                    if (second) tw[m][bj] = *(const u32x4*)(T1 + (size_t)row * D + col0 + bj * HALF); else tw[m][bj] = (u32x4){0u, 0u, 0u, 0u}; }
#pragma unroll
            for (int m = mb; m < mb + 2; ++m)
#pragma unroll
                for (int bj = 0; bj < 2; ++bj) { const int row = row0 + ai * HALF + m * 16;
                    const u32x4 g = gw[m][bj], t = tw[m][bj]; f32x4 v0 = acc[ai][bj][m][0], v1 = acc[ai][bj][m][1];
                    v0[0] = v0[0] * bflo(g.x) + bflo(t.x); v0[1] = v0[1] * bfhi(g.x) + bfhi(t.x); v0[2] = v0[2] * bflo(g.y) + bflo(t.y); v0[3] = v0[3] * bfhi(g.y) + bfhi(t.y);
                    v1[0] = v1[0] * bflo(g.z) + bflo(t.z); v1[1] = v1[1] * bfhi(g.z) + bfhi(t.z); v1[2] = v1[2] * bflo(g.w) + bflo(t.w); v1[3] = v1[3] * bfhi(g.w) + bfhi(t.w);
                    *(u32x4*)(T1 + (size_t)row * D + col0 + bj * HALF) = pack8(v0, v1); }
        }
    }
};
struct EpiOut {
    static constexpr bool PERM = true, AFTER_DRAIN = false, HAS_INIT = true;
    const float* x; float* y; bf16_t* X1B; float* x1ss;
    __device__ __forceinline__ void init(f32x4 (&acc)[2][2][4][2], const Unit& u, int wr, int wc, int fr, int fq) const {
        const int row0 = u.pm * BM + wr * 64 + fr, col0 = u.pn * BM + wc * 32 + 8 * fq;
#pragma unroll
        for (int ai = 0; ai < 2; ++ai)
#pragma unroll
            for (int m = 0; m < 4; ++m)
#pragma unroll
                for (int bj = 0; bj < 2; ++bj) { const size_t off = (size_t)(row0 + ai * HALF + m * 16) * D + col0 + bj * HALF;
                    acc[ai][bj][m][0] = *(const f32x4*)(x + off); acc[ai][bj][m][1] = *(const f32x4*)(x + off + 4); }
    }
    __device__ __forceinline__ void operator()(const f32x4 (&acc)[2][2][4][2], const Unit& u, int wr, int wc, int fr, int fq) const {
        const int row0 = u.pm * BM + wr * 64 + fr, col0 = u.pn * BM + wc * 32 + 8 * fq;
#pragma unroll
        for (int ai = 0; ai < 2; ++ai)
#pragma unroll
            for (int m = 0; m < 4; ++m) { const int row = row0 + ai * HALF + m * 16; float ss = 0.f;
#pragma unroll
                for (int bj = 0; bj < 2; ++bj) { const size_t off = (size_t)row * D + col0 + bj * HALF;
                    const f32x4 v0 = acc[ai][bj][m][0], v1 = acc[ai][bj][m][1];
                    *(f32x4*)(y + off) = v0; *(f32x4*)(y + off + 4) = v1; *(u32x4*)(X1B + off) = pack8(v0, v1);
#pragma unroll
                    for (int e = 0; e < 4; ++e) ss += v0[e] * v0[e] + v1[e] * v1[e]; }
                ss += __shfl_xor(ss, 16); ss += __shfl_xor(ss, 32); if (fq == 0) x1ss[(size_t)row * 16 + u.pn * 4 + wc] = ss;
            }
    }
};
struct EpiUp {
    static constexpr bool PERM = true, AFTER_DRAIN = false, HAS_INIT = false;
    bf16_t* F;
    __device__ __forceinline__ void operator()(const f32x4 (&acc)[2][2][4][2], const Unit& u, int wr, int wc, int fr, int fq) const {
        const int row0 = u.pm * BM + wr * 64 + fr, col0 = u.pn * BM + wc * 32 + 8 * fq;
#pragma unroll
        for (int ai = 0; ai < 2; ++ai)
#pragma unroll
            for (int m = 0; m < 4; ++m) { const int row = row0 + ai * HALF + m * 16;
#pragma unroll
                for (int bj = 0; bj < 2; ++bj) { f32x4 v0 = acc[ai][bj][m][0], v1 = acc[ai][bj][m][1];
#pragma unroll
                    for (int e = 0; e < 4; ++e) { const float a = fmaxf(v0[e], 0.f), b = fmaxf(v1[e], 0.f); v0[e] = a * a; v1[e] = b * b; }
                    *(u32x4*)(F + (size_t)row * FF + col0 + bj * HALF) = pack8(v0, v1); }
            }
    }
};
struct EpiDown {
    static constexpr bool PERM = true, AFTER_DRAIN = false, HAS_INIT = true;
    float* y; const float* x1q;
    __device__ __forceinline__ float ms_eps(int row) const { return x1q[row]; }
    __device__ __forceinline__ void init(f32x4 (&acc)[2][2][4][2], const Unit& u, int wr, int wc, int fr, int fq) const {
        const int row0 = u.pm * BM + wr * 64 + fr, col0 = u.pn * BM + wc * 32 + 8 * fq;
#pragma unroll
        for (int ai = 0; ai < 2; ++ai)
#pragma unroll
            for (int m = 0; m < 4; ++m) { const int row = row0 + ai * HALF + m * 16; const float q = ms_eps(row);
#pragma unroll
                for (int bj = 0; bj < 2; ++bj) { const size_t off = (size_t)row * D + col0 + bj * HALF;
                    acc[ai][bj][m][0] = *(const f32x4*)(y + off) * q; acc[ai][bj][m][1] = *(const f32x4*)(y + off + 4) * q; } }
    }
    __device__ __forceinline__ void operator()(const f32x4 (&acc)[2][2][4][2], const Unit& u, int wr, int wc, int fr, int fq) const {
        const int row0 = u.pm * BM + wr * 64 + fr, col0 = u.pn * BM + wc * 32 + 8 * fq;
#pragma unroll
        for (int ai = 0; ai < 2; ++ai)
#pragma unroll
            for (int m = 0; m < 4; ++m) { const int row = row0 + ai * HALF + m * 16; const float r2 = 1.0f / ms_eps(row);
#pragma unroll
                for (int bj = 0; bj < 2; ++bj) { const size_t off = (size_t)row * D + col0 + bj * HALF;
                    *(f32x4*)(y + off) = acc[ai][bj][m][0] * r2; *(f32x4*)(y + off + 4) = acc[ai][bj][m][1] * r2; }
            }
    }
};

template <class Epi, class Sched, bool ALIGN_EPI = false, bool SP2 = false>
__device__ __forceinline__ void gemm_phase(PG8_LAS unsigned char* lds, const Gemm g, const Sched& S, const Epi& E) {
    const int tid = opaque_tid(), wid = __builtin_amdgcn_readfirstlane(tid >> 6), lane = tid & 63, wr = wid >> 2, wc = wid & 3, fr = lane & 15, fq = lane >> 4;
    const int K = g.K, nt = K / BK;
    unsigned voffA[2], voffB[2];
#pragma unroll
    for (int i = 0; i < 2; ++i) { int R, C; stage_rc(tid * 16 + i * 8192, R, C); const int Rb = Epi::PERM ? ((R & ~31) + perm32(R & 31)) : R;
        voffA[i] = (unsigned)(R * g.lda + C) * 2u; voffB[i] = (unsigned)(Rb * K + C) * 2u; }
    const size_t kstep = (size_t)(BK * 2);
    const size_t hstepA = (size_t)HALF * g.lda * 2, hstepB = (size_t)HALF * K * 2;
    const size_t tstepA = 2 * hstepA, tstepB = 2 * hstepB;
    const unsigned ldsw = (unsigned)wid * 1024u;
    const int aoff = lds_byte(wr * 64 + fr, fq * 8), boff = lds_byte(wc * 32 + fr, fq * 8);
#define PG8_SA(b, h) (((b) * 2 + (h)) * HTB)
#define PG8_SB(b, h) ((4 + (b) * 2 + (h)) * HTB)
#define PG8_STAGE(bufoff, gbase, voff) do { _Pragma("unroll") for (int _i = 0; _i < 2; ++_i) \
        __builtin_amdgcn_global_load_lds((const unsigned*)((const char*)(gbase) + (voff)[_i]), (PG8_LAS unsigned*)(lds + (bufoff) + ldsw + _i * 8192), 16, 0, 0); } while (0)
#define PG8_LDA(dst, b, h) do { _Pragma("unroll") for (int m = 0; m < 4; ++m) _Pragma("unroll") for (int k = 0; k < 2; ++k) dst[m][k] = *(const PG8_LAS bf16x8*)(lds + PG8_SA(b, h) + aoff + m * 2048 + k * 1024); } while (0)
#define PG8_LDB(dst, b, h) do { _Pragma("unroll") for (int n = 0; n < 2; ++n) _Pragma("unroll") for (int k = 0; k < 2; ++k) dst[n][k] = *(const PG8_LAS bf16x8*)(lds + PG8_SB(b, h) + boff + n * 2048 + k * 1024); } while (0)
#define PG8_MMA(ai, bj, At, Bt) do { __builtin_amdgcn_s_setprio(1); _Pragma("unroll") for (int m = 0; m < 4; ++m) _Pragma("unroll") for (int n = 0; n < 2; ++n) _Pragma("unroll") for (int k = 0; k < 2; ++k) \
        acc[ai][bj][m][n] = __builtin_amdgcn_mfma_f32_16x16x32_bf16(Bt[n][k], At[m][k], acc[ai][bj][m][n], 0, 0, 0); __builtin_amdgcn_s_setprio(0); } while (0)
#define PG8_WAIT_V(n) asm volatile("s_waitcnt vmcnt(" #n ")" ::: "memory")
#define PG8_WAIT_L(n) asm volatile("s_waitcnt lgkmcnt(" #n ")" ::: "memory")
#define PG8_BAR __builtin_amdgcn_s_barrier()
#define PG8_SCHED __builtin_amdgcn_sched_barrier(0)
    Unit cur, nxt; int ui = 0;
    if (!S.next(0, cur)) return;
    f32x4 acc[2][2][4][2];
    if constexpr (Epi::HAS_INIT) { E.init(acc, cur, wr, wc, fr, fq); } else {
#pragma unroll
    for (int a = 0; a < 2; ++a)
#pragma unroll
        for (int b = 0; b < 2; ++b)
#pragma unroll
            for (int m = 0; m < 4; ++m)
#pragma unroll
                for (int n = 0; n < 2; ++n) acc[a][b][m][n] = (f32x4){0.f, 0.f, 0.f, 0.f};
    }
    bf16x8 At[4][2], B0[2][2], B1[2][2];
    const char* cA = (const char*)g.A + (size_t)cur.pm * tstepA + (size_t)cur.sub * g.a_sub_off; const char* cB = (const char*)g.Bt + (size_t)(cur.pn + cur.sub * g.b_sub_tiles) * tstepB;
    S.a_ready(cur);
    if constexpr (SP2) {
        PG8_STAGE(PG8_SB(0, 0), cB, voffB); PG8_STAGE(PG8_SB(0, 1), cB + hstepB, voffB); PG8_STAGE(PG8_SA(0, 0), cA, voffA); PG8_STAGE(PG8_SA(0, 1), cA + hstepA, voffA);
        if (wr == 1) PG8_BAR;
        PG8_WAIT_V(2); PG8_BAR;
        PG8_STAGE(PG8_SB(1, 0), cB + kstep, voffB); PG8_STAGE(PG8_SA(1, 0), cA + kstep, voffA); PG8_STAGE(PG8_SB(1, 1), cB + hstepB + kstep, voffB);
        PG8_WAIT_V(6); PG8_BAR;
    } else {
        PG8_STAGE(PG8_SB(0, 0), cB, voffB); PG8_STAGE(PG8_SA(0, 0), cA, voffA); PG8_STAGE(PG8_SB(0, 1), cB + hstepB, voffB); PG8_STAGE(PG8_SA(0, 1), cA + hstepA, voffA);
        if (wr == 1) PG8_BAR;
        PG8_WAIT_V(4); PG8_BAR;
        PG8_STAGE(PG8_SB(1, 0), cB + kstep, voffB); PG8_STAGE(PG8_SA(1, 0), cA + kstep, voffA); PG8_STAGE(PG8_SB(1, 1), cB + hstepB + kstep, voffB);
        PG8_WAIT_V(6); PG8_BAR;
    }
    for (;;) {
        const bool has_next = S.next(ui + 1, nxt);
        const char* nA = has_next ? (const char*)g.A + (size_t)nxt.pm * tstepA + (size_t)nxt.sub * g.a_sub_off : cA; const char* nB = has_next ? (const char*)g.Bt + (size_t)(nxt.pn + nxt.sub * g.b_sub_tiles) * tstepB : cB;
        for (int t = 0; t < nt; t += 2) {
            const bool last = (t == nt - 2);
            const char* a1 = cA + (size_t)(t + 1) * kstep;
            const char* a2 = last ? nA : cA + (size_t)(t + 2) * kstep; const char* b2 = last ? nB : cB + (size_t)(t + 2) * kstep;
            const char* a3 = a2 + kstep; const char* b3 = b2 + kstep;
            if (last && has_next) S.a_ready(nxt);
            if constexpr (SP2) {
            PG8_LDB(B0, 0, 0); PG8_LDB(B1, 0, 1); PG8_SCHED; PG8_LDA(At, 0, 0); PG8_STAGE(PG8_SA(1, 1), a1 + hstepA, voffA);
            PG8_WAIT_V(8); PG8_WAIT_L(0); PG8_BAR; PG8_MMA(0, 0, At, B0); PG8_MMA(0, 1, At, B1); PG8_BAR; PG8_SCHED;
            PG8_LDA(At, 0, 1); PG8_STAGE(PG8_SB(0, 0), b2, voffB); PG8_STAGE(PG8_SB(0, 1), b2 + hstepB, voffB); PG8_STAGE(PG8_SA(0, 0), a2, voffA);
            PG8_WAIT_V(8); PG8_WAIT_L(0); PG8_BAR; PG8_MMA(1, 0, At, B0); PG8_MMA(1, 1, At, B1); PG8_BAR; PG8_SCHED;
            PG8_LDB(B0, 1, 0); PG8_LDB(B1, 1, 1); PG8_SCHED; PG8_LDA(At, 1, 0); PG8_STAGE(PG8_SA(0, 1), a2 + hstepA, voffA);
            PG8_WAIT_V(8); PG8_WAIT_L(0); PG8_BAR; PG8_MMA(0, 0, At, B0); PG8_MMA(0, 1, At, B1); PG8_BAR; PG8_SCHED;
            PG8_LDA(At, 1, 1); PG8_STAGE(PG8_SB(1, 0), b3, voffB); PG8_STAGE(PG8_SB(1, 1), b3 + hstepB, voffB); PG8_STAGE(PG8_SA(1, 0), a3, voffA);
            PG8_WAIT_V(8); PG8_WAIT_L(0); PG8_BAR; PG8_MMA(1, 0, At, B0); PG8_MMA(1, 1, At, B1); PG8_BAR; PG8_SCHED;
            } else {
            PG8_LDB(B0, 0, 0); PG8_SCHED; PG8_LDA(At, 0, 0); PG8_STAGE(PG8_SA(1, 1), a1 + hstepA, voffA);
            PG8_WAIT_L(8); PG8_BAR; PG8_WAIT_L(0); PG8_MMA(0, 0, At, B0); PG8_BAR; PG8_SCHED;
            PG8_LDB(B1, 0, 1); PG8_STAGE(PG8_SB(0, 0), b2, voffB);
            PG8_BAR; PG8_WAIT_L(0); PG8_MMA(0, 1, At, B1); PG8_BAR;
            PG8_LDA(At, 0, 1); PG8_STAGE(PG8_SA(0, 0), a2, voffA);
            PG8_BAR; PG8_WAIT_L(0); PG8_MMA(1, 0, At, B0); PG8_BAR; PG8_SCHED;
            PG8_STAGE(PG8_SB(0, 1), b2 + hstepB, voffB);
            PG8_WAIT_V(6); PG8_BAR; PG8_MMA(1, 1, At, B1); PG8_BAR;
            PG8_LDB(B0, 1, 0); PG8_SCHED; PG8_LDA(At, 1, 0); PG8_STAGE(PG8_SA(0, 1), a2 + hstepA, voffA);
            PG8_WAIT_L(8); PG8_BAR; PG8_WAIT_L(0); PG8_MMA(0, 0, At, B0); PG8_BAR; PG8_SCHED;
            PG8_LDB(B1, 1, 1); PG8_STAGE(PG8_SB(1, 0), b3, voffB);
            PG8_BAR; PG8_WAIT_L(0); PG8_MMA(0, 1, At, B1); PG8_BAR;
            PG8_LDA(At, 1, 1); PG8_STAGE(PG8_SA(1, 0), a3, voffA);
            PG8_BAR; PG8_WAIT_L(0); PG8_MMA(1, 0, At, B0); PG8_BAR; PG8_SCHED;
            PG8_STAGE(PG8_SB(1, 1), b3 + hstepB, voffB);
            PG8_WAIT_V(6); PG8_BAR; PG8_MMA(1, 1, At, B1); PG8_BAR;
            }
        }
        if constexpr (ALIGN_EPI) { if (wr == 0) PG8_BAR; }
        if constexpr (!Epi::AFTER_DRAIN) { E(acc, cur, wr, wc, fr, fq); S.done(cur); }
        if (!has_next) break;
        if constexpr (Epi::HAS_INIT) { E.init(acc, nxt, wr, wc, fr, fq); } else {
#pragma unroll
        for (int a = 0; a < 2; ++a)
#pragma unroll
            for (int b = 0; b < 2; ++b)
#pragma unroll
                for (int m = 0; m < 4; ++m)
#pragma unroll
                    for (int n = 0; n < 2; ++n) acc[a][b][m][n] = (f32x4){0.f, 0.f, 0.f, 0.f};
        }
        cur = nxt; cA = nA; cB = nB; ++ui;
        if constexpr (ALIGN_EPI) { if (wr == 1) PG8_BAR; }
    }
    PG8_WAIT_V(0);
    if constexpr (!ALIGN_EPI) { if (wr == 0) PG8_BAR; }
    PG8_BAR;
    if constexpr (Epi::AFTER_DRAIN) { E.fused(acc, cur, wr, wc, fr, fq, lds, wid, lane); S.done(cur); }
#undef PG8_SA
#undef PG8_SB
#undef PG8_STAGE
#undef PG8_LDA
#undef PG8_LDB
#undef PG8_MMA
#undef PG8_WAIT_V
#undef PG8_WAIT_L
#undef PG8_BAR
#undef PG8_SCHED
}

}

struct Args { const float* in[17]; float* out; unsigned char* ws; };
struct Ctx {
    const float *xp, *xs, *ck, *cv, *g1, *w_in, *gs, *sgu_w, *sgu_b, *sinks, *w_oa, *w_ob, *w_out, *g2, *w_up, *w_down, *gf;
    float* out; unsigned char* ws;
    int G, bid;
};
#define MFMA16(a, b, c) __builtin_amdgcn_mfma_f32_16x16x32_bf16((a), (b), (c), 0, 0, 0)

__device__ __forceinline__ void p0_transpose_item(const float* W, int K, int N, bf16_t* WT, int row_off, const float* kscale, LAS float* scr, int item, int lane) {
    const int nblk = N / 32, kb = item / nblk, nb = item % nblk, k0 = 64 * kb, n0 = 32 * nb;
#pragma unroll 8
    for (int i = 0; i < 32; ++i) { const int kk = 2 * i + (lane >> 5); float v = W[(size_t)(k0 + kk) * N + n0 + (lane & 31)]; if (kscale) v *= kscale[k0 + kk]; scr[kk * 33 + (lane & 31)] = v; }
    asm volatile("s_waitcnt lgkmcnt(0)" ::: "memory");
    const int c = lane & 7;
#pragma unroll
    for (int j = 0; j < 4; ++j) { const int n = (lane >> 3) + 8 * j; const LAS float* s = scr + (8 * c) * 33 + n;
        u32x4 o; o.x = cvt_pk_bf16(s[0 * 33], s[1 * 33]); o.y = cvt_pk_bf16(s[2 * 33], s[3 * 33]); o.z = cvt_pk_bf16(s[4 * 33], s[5 * 33]); o.w = cvt_pk_bf16(s[6 * 33], s[7 * 33]);
        *(u32x4*)(WT + (size_t)(row_off + n0 + n) * K + k0 + 8 * c) = o; }
    asm volatile("s_waitcnt lgkmcnt(0)" ::: "memory");
}
__device__ __forceinline__ void rms_row_to_bf16(const float* xrow, const float* g, bf16_t* orow, int lane) {
    const f32x4* xr = (const f32x4*)xrow + lane; const f32x4* gr = (const f32x4*)g + lane;
    f32x4 v[4]; float s = 0.f;
#pragma unroll
    for (int j = 0; j < 4; ++j) { v[j] = xr[64 * j]; s += (v[j].x * v[j].x + v[j].y * v[j].y) + (v[j].z * v[j].z + v[j].w * v[j].w); }
    const float r = 1.0f / sqrtf(wave_sum(s) * (1.0f / D) + EPS);
    u32x2* o8 = (u32x2*)orow + lane;
#pragma unroll
    for (int j = 0; j < 4; ++j) { const f32x4 gg = gr[64 * j]; u32x2 w; w.x = cvt_pk_bf16(v[j].x * r * gg.x, v[j].y * r * gg.y); w.y = cvt_pk_bf16(v[j].z * r * gg.z, v[j].w * r * gg.w); o8[64 * j] = w; }
}
__device__ __forceinline__ void p0_prologue(const Ctx& F, LAS unsigned char* lds) {
    const int tid_ = opaque_tid(), lane_ = tid_ & 63, wave_ = __builtin_amdgcn_readfirstlane(tid_ >> 6);
    LAS float* scr = (LAS float*)(lds + wave_ * 16384);
    const int gw = F.bid * 8 + wave_, NGW = F.G * 8;
    constexpr int I_IN = (D / 64) * (INW / 32), I_D = (D / 64) * (D / 32), I_UP = (D / 64) * (FF / 32), I_DN = (FF / 64) * (D / 32);
    constexpr int NITEMS = I_IN + 3 * I_D + I_UP + I_DN;
    bf16_t* WinT = (bf16_t*)(F.ws + WS_WIN); bf16_t* WoabT = (bf16_t*)(F.ws + WS_WOAB); bf16_t* WoutT = (bf16_t*)(F.ws + WS_WOUT);
    bf16_t* WupT = (bf16_t*)(F.ws + WS_WUP); bf16_t* WdownT = (bf16_t*)(F.ws + WS_WDOWN);
    for (int it = gw; it < NITEMS; it += NGW) {
        int r = it;
        if (r < I_IN) { p0_transpose_item(F.w_in, D, INW, WinT, 0, nullptr, scr, r, lane_); continue; } r -= I_IN;
        if (r < I_D) { p0_transpose_item(F.w_oa, D, D, WoabT, 0, nullptr, scr, r, lane_); continue; } r -= I_D;
        if (r < I_D) { p0_transpose_item(F.w_ob, D, D, WoabT, D, nullptr, scr, r, lane_); continue; } r -= I_D;
        if (r < I_D) { p0_transpose_item(F.w_out, D, D, WoutT, 0, nullptr, scr, r, lane_); continue; } r -= I_D;
        if (r < I_UP) { p0_transpose_item(F.w_up, D, FF, WupT, 0, F.g2, scr, r, lane_); continue; } r -= I_UP;
        p0_transpose_item(F.w_down, FF, D, WdownT, 0, nullptr, scr, r, lane_);
    }
    bf16_t* XN = (bf16_t*)(F.ws + WS_XN); bf16_t* XNs = (bf16_t*)(F.ws + WS_XNS);
    for (int m = gw; m < MP + NS; m += NGW) {
        if (m < MP) rms_row_to_bf16(F.xp + (size_t)m * D, F.g1, XN + (size_t)m * D, lane_);
        else rms_row_to_bf16(F.xs + (size_t)(m - MP) * D, F.g1, XNs + (size_t)(m - MP) * D, lane_);
    }
    bf16_t* Wt = (bf16_t*)(F.ws + WS_WTRIL);
    for (int i = F.bid * 512 + tid_; i < 8 * 128 * 128; i += F.G * 512) { const int t = (i >> 7) & 127, s = i & 127; const float v = (s <= t) ? F.sgu_w[i] : 0.f; Wt[i] = (bf16_t)(cvt_pk_bf16(v, 0.f) & 0xffffu); }
}

constexpr int SKP = 264;
template <int NT> __device__ __forceinline__ void skinny_lds(LAS unsigned char* lds, const bf16_t* A, int lda, const bf16_t* Bt, int ldb, f32x4 (&acc)[NT]) {
    const int tid = opaque_tid(), lane = tid & 63, wave = __builtin_amdgcn_readfirstlane(tid >> 6), l15 = lane & 15, g = lane >> 4;
    LAS bf16_t* Ai = (LAS bf16_t*)lds; LAS bf16_t* Bi = (LAS bf16_t*)(lds + 128 * SKP * 2);
    const int prow = tid >> 5, pc = tid & 31;
    const bf16_t* ag = A + (size_t)prow * lda + pc * 8; const bf16_t* bg = Bt + (size_t)prow * ldb + pc * 8;
    u32x4 ra[8], rb[NT];
#pragma unroll
    for (int i = 0; i < 8; ++i) ra[i] = *(const u32x4*)(ag + (size_t)(16 * i) * lda);
#pragma unroll
    for (int i = 0; i < NT; ++i) rb[i] = *(const u32x4*)(bg + (size_t)(16 * i) * ldb);
#pragma unroll
    for (int t = 0; t < NT; ++t) acc[t] = (f32x4){0.f, 0.f, 0.f, 0.f};
    for (int c = 0; c < 4; ++c) {
#pragma unroll
        for (int i = 0; i < 8; ++i) *(LAS u32x4*)(Ai + (prow + 16 * i) * SKP + pc * 8) = ra[i];
#pragma unroll
        for (int i = 0; i < NT; ++i) *(LAS u32x4*)(Bi + (prow + 16 * i) * SKP + pc * 8) = rb[i];
        __syncthreads();
        if (c < 3) {
#pragma unroll
            for (int i = 0; i < 8; ++i) ra[i] = *(const u32x4*)(ag + (size_t)(16 * i) * lda + 256 * (c + 1));
#pragma unroll
            for (int i = 0; i < NT; ++i) rb[i] = *(const u32x4*)(bg + (size_t)(16 * i) * ldb + 256 * (c + 1));
        }
        const LAS bf16_t* ar = Ai + (16 * wave + l15) * SKP + 8 * g; const LAS bf16_t* br = Bi + l15 * SKP + 8 * g;
#pragma unroll
        for (int ks = 0; ks < 8; ++ks) { const bf16x8 a = *(const LAS bf16x8*)(ar + 32 * ks);
#pragma unroll
            for (int t = 0; t < NT; ++t) { const bf16x8 b = *(const LAS bf16x8*)(br + 16 * t * SKP + 32 * ks); acc[t] = MFMA16(b, a, acc[t]); } }
        __syncthreads();
    }
}
__device__ __forceinline__ float act_in(float v, int col) { return col < C_Q ? gelu_t(v) : (col < C_GA ? v : sigmoid_f(v)); }

constexpr int KP = 72;
__device__ __forceinline__ void attn_unit(const Ctx& F, LAS unsigned char* lds, bf16_t* H, int b, int kvh, int qb) {
    const int tid_ = opaque_tid(), lane_ = tid_ & 63, wave_ = __builtin_amdgcn_readfirstlane(tid_ >> 6);
    LAS bf16_t* Ks = (LAS bf16_t*)lds; LAS bf16_t* Vs = (LAS bf16_t*)(lds + 256 * KP * 2);
    const int tid = tid_, lane = lane_, l15 = lane & 15, g = lane >> 4, qt = wave_;
    const long rowbase = (long)b * SEQ + (long)(qb - 1) * 128;
#pragma unroll
    for (int i = 0; i < 4; ++i) { const int c = tid + 512 * i, j = c >> 3, ch = c & 7;
        u32x4 kv = {0u, 0u, 0u, 0u}, vv = {0u, 0u, 0u, 0u};
        if (qb > 0 || j >= 128) { const bf16_t* p = H + (size_t)(rowbase + j) * INW + C_K + kvh * 64 + ch * 8; kv = *(const u32x4*)p; vv = *(const u32x4*)(p + 256); }
        *(LAS u32x4*)(Ks + j * KP + ch * 8) = kv; *(LAS u32x4*)(Vs + j * KP + ch * 8) = vv; }
    if (tid < 128) *(LAS u32x4*)(Vs + (256 + (tid >> 3)) * KP + (tid & 7) * 8) = (u32x4){0u, 0u, 0u, 0u};
    __syncthreads();
    const int qq = l15 >> 2, pp = lane & 3;
    for (int hh = 0; hh < 4; ++hh) {
        const int h = kvh * 4 + hh; const float slope = __builtin_amdgcn_exp2f(-0.5f * (float)(h + 1)); const float sink = F.sinks[h];
        bf16_t* qp = H + (size_t)(b * SEQ + qb * 128 + 16 * qt + l15) * INW + C_Q + h * 64;
        const bf16x8 q0 = *(const bf16x8*)(qp + 8 * g), q1 = *(const bf16x8*)(qp + 8 * g + 32);
        f32x4 st[9];
#pragma unroll
        for (int kt = 0; kt < 9; ++kt) { const LAS bf16_t* kp = Ks + (16 * (qt + kt) + l15) * KP + 8 * g;
            const bf16x8 k0 = *(const LAS bf16x8*)kp, k1 = *(const LAS bf16x8*)(kp + 32);
            f32x4 z = {0.f, 0.f, 0.f, 0.f}; z = MFMA16(k0, q0, z); st[kt] = MFMA16(k1, q1, z); }
        float mx = sink;
#pragma unroll
        for (int kt = 0; kt < 9; ++kt)
#pragma unroll
            for (int i = 0; i < 4; ++i) { const int diff = 128 + l15 - 16 * kt - 4 * g - i; const int j = 16 * (qt + kt) + 4 * g + i;
                const bool valid = (diff >= 0) && (diff <= 128) && (qb > 0 || j >= 128);
                const float s = valid ? (st[kt][i] * 0.125f - slope * (float)diff) : -1e30f; st[kt][i] = s; mx = fmaxf(mx, s); }
        mx = fmaxf(mx, __shfl_xor(mx, 16)); mx = fmaxf(mx, __shfl_xor(mx, 32));
        float sum = 0.f;
#pragma unroll
        for (int kt = 0; kt < 9; ++kt)
#pragma unroll
            for (int i = 0; i < 4; ++i) { const float p = __builtin_amdgcn_exp2f((st[kt][i] - mx) * LOG2E); st[kt][i] = p; sum += p; }
        sum += __shfl_xor(sum, 16); sum += __shfl_xor(sum, 32);
        sum += __builtin_amdgcn_exp2f((sink - mx) * LOG2E);
        const float inv = 1.0f / sum;
        f32x4 o[4];
#pragma unroll
        for (int c = 0; c < 4; ++c) o[c] = (f32x4){0.f, 0.f, 0.f, 0.f};
#pragma unroll
        for (int ks = 0; ks < 5; ++ks) {
            u32x4 pw; pw.x = cvt_pk_bf16(st[2 * ks][0] * inv, st[2 * ks][1] * inv); pw.y = cvt_pk_bf16(st[2 * ks][2] * inv, st[2 * ks][3] * inv);
            if (ks < 4) { pw.z = cvt_pk_bf16(st[2 * ks + 1][0] * inv, st[2 * ks + 1][1] * inv); pw.w = cvt_pk_bf16(st[2 * ks + 1][2] * inv, st[2 * ks + 1][3] * inv); } else { pw.z = 0u; pw.w = 0u; }
            const bf16x8 pf = __builtin_bit_cast(bf16x8, pw);
            const LAS bf16_t* vb = Vs + (16 * (qt + 2 * ks) + 4 * g + qq) * KP + 4 * pp;
#pragma unroll
            for (int c = 0; c < 4; ++c) { const s16x4 lo = tr_read(vb + 16 * c), hi = tr_read(vb + 16 * KP + 16 * c);
                const bf16x8 vf = {lo[0], lo[1], lo[2], lo[3], hi[0], hi[1], hi[2], hi[3]};
                o[c] = MFMA16(vf, pf, o[c]); }
        }
#pragma unroll
        for (int c = 0; c < 4; ++c) { u32x2 w; w.x = cvt_pk_bf16(o[c][0], o[c][1]); w.y = cvt_pk_bf16(o[c][2], o[c][3]); *(u32x2*)(qp + 16 * c + 4 * g) = w; }
    }
    __syncthreads();
}

constexpr int VNP = 136;
__device__ __forceinline__ void sgu_unit(const Ctx& F, LAS unsigned char* lds, bf16_t* H, const float* vss, const bf16_t* Wt, int b, int ch_, int gi) {
    const int tid_ = opaque_tid(), lane_ = tid_ & 63, wave_ = __builtin_amdgcn_readfirstlane(tid_ >> 6);
    LAS bf16_t* VN = (LAS bf16_t*)lds; LAS float* rs = (LAS float*)(lds + 128 * VNP * 2);
    const int tid = tid_, lane = lane_, l15 = lane & 15, g = lane >> 4, tt = wave_;
    const size_t rowbase = (size_t)b * SEQ + (size_t)ch_ * 128;
    if (tid < 128) { const f32x4* sp = (const f32x4*)(vss + (rowbase + tid) * 16); const f32x4 s4 = (sp[0] + sp[1]) + (sp[2] + sp[3]);
        rs[tid] = 1.0f / sqrtf(((s4[0] + s4[1]) + (s4[2] + s4[3])) * (1.0f / D) + EPS); }
    __syncthreads();
    { const int cc = tid & 15; const f32x4 g0 = *(const f32x4*)(F.gs + gi * 128 + cc * 8), g1v = *(const f32x4*)(F.gs + gi * 128 + cc * 8 + 4);
#pragma unroll
      for (int i = 0; i < 4; ++i) { const int s = (tid >> 4) + 32 * i; const float r = rs[s];
          const u32x4 w = *(const u32x4*)(H + (rowbase + s) * INW + C_V + gi * 128 + cc * 8);
          u32x4 o; o.x = cvt_pk_bf16(bflo(w.x) * r * g0[0], bfhi(w.x) * r * g0[1]); o.y = cvt_pk_bf16(bflo(w.y) * r * g0[2], bfhi(w.y) * r * g0[3]);
          o.z = cvt_pk_bf16(bflo(w.z) * r * g1v[0], bfhi(w.z) * r * g1v[1]); o.w = cvt_pk_bf16(bflo(w.w) * r * g1v[2], bfhi(w.w) * r * g1v[3]);
          *(LAS u32x4*)(VN + s * VNP + cc * 8) = o; } }
    __syncthreads();
    const int nks = (tt >> 1) + 1; const int qq = l15 >> 2, pp = lane & 3;
    bf16x8 wf[4];
#pragma unroll
    for (int ks = 0; ks < 4; ++ks) wf[ks] = (ks < nks) ? *(const bf16x8*)(Wt + ((size_t)gi * 128 + 16 * tt + l15) * 128 + 32 * ks + 8 * g) : (bf16x8){0, 0, 0, 0, 0, 0, 0, 0};
    const float bias = F.sgu_b[gi * 128 + 16 * tt + l15];
    bf16_t* up = H + (rowbase + 16 * tt + l15) * INW + C_U + gi * 128 + 4 * g;
#pragma unroll
    for (int c = 0; c < 8; ++c) { f32x4 acc = {0.f, 0.f, 0.f, 0.f};
#pragma unroll
        for (int ks = 0; ks < 4; ++ks) if (ks < nks) { const LAS bf16_t* vb = VN + (32 * ks + 8 * g + qq) * VNP + 16 * c + 4 * pp;
            const s16x4 lo = tr_read(vb), hi = tr_read(vb + 4 * VNP);
            const bf16x8 vf = {lo[0], lo[1], lo[2], lo[3], hi[0], hi[1], hi[2], hi[3]};
            acc = MFMA16(vf, wf[ks], acc); }
        const u32x2 uw = *(const u32x2*)(up + 16 * c);
        u32x2 w; w.x = cvt_pk_bf16(bflo(uw.x) * (acc[0] + bias), bfhi(uw.x) * (acc[1] + bias)); w.y = cvt_pk_bf16(bflo(uw.y) * (acc[2] + bias), bfhi(uw.y) * (acc[3] + bias));
        *(u32x2*)(up + 16 * c) = w; }
    __syncthreads();
}

__device__ __forceinline__ void sample_row(const Ctx& F, LAS unsigned char* lds, int b) {
    const int tid_ = opaque_tid(), lane_ = tid_ & 63, wave_ = __builtin_amdgcn_readfirstlane(tid_ >> 6);
    LAS float* qs = (LAS float*)lds;
    LAS float* sc = qs + 1024;
    LAS float* red = sc + 16 * 132;
    const int tid = tid_, lane = lane_;
    const float* Hs = (const float*)(F.ws + WS_HS) + (size_t)b * INW; bf16_t* ABs = (bf16_t*)(F.ws + WS_ABS) + (size_t)b * 2048;
    const int d0 = tid * 2; const float gv0 = Hs[C_V + d0], gv1 = Hs[C_V + d0 + 1];
    float ss = wave_sum(gv0 * gv0 + gv1 * gv1); if (lane == 0) red[wave_] = ss;
    qs[tid] = Hs[C_Q + tid]; qs[tid + 512] = Hs[C_Q + tid + 512];
    __syncthreads();
    { float tot = 0.f;
#pragma unroll
      for (int w = 0; w < 8; ++w) tot += red[w];
      const float r = 1.0f / sqrtf(tot * (1.0f / D) + EPS); const int gi = d0 >> 7;
      const float vn0 = gv0 * r * F.gs[d0], vn1 = gv1 * r * F.gs[d0 + 1];
      F.out[O_SGV + (size_t)b * D + d0] = vn0; F.out[O_SGV + (size_t)b * D + d0 + 1] = vn1;
      const float w00 = F.sgu_w[gi * 16384], b0 = F.sgu_b[gi * 128];
      *(unsigned*)(ABs + d0) = cvt_pk_bf16(Hs[C_U + d0] * (w00 * vn0 + b0), Hs[C_U + d0 + 1] * (w00 * vn1 + b0)); }
    const int h = tid >> 5, jj = tid & 31, kvh = h >> 2; const float slope = __builtin_amdgcn_exp2f(-0.5f * (float)(h + 1)); const float sink = F.sinks[h];
    const LAS f32x4* q4 = (const LAS f32x4*)(qs + h * 64);
    float sv[5]; float mx = sink;
#pragma unroll
    for (int r = 0; r < 4; ++r) { const int j = jj + 32 * r; const f32x4* kp = (const f32x4*)(F.ck + ((size_t)(b * 128 + j) * 4 + kvh) * 64); float dot = 0.f;
#pragma unroll
        for (int e = 0; e < 16; ++e) { const f32x4 kk = kp[e], q = q4[e]; dot += (kk.x * q.x + kk.y * q.y) + (kk.z * q.z + kk.w * q.w); }
        sv[r] = dot * 0.125f - slope * (float)(128 - j); mx = fmaxf(mx, sv[r]); }
    { const f32x4* kp = (const f32x4*)(Hs + C_K + kvh * 64); float dot = 0.f;
#pragma unroll
      for (int e = 0; e < 16; ++e) { const f32x4 kk = kp[e], q = q4[e]; dot += (kk.x * q.x + kk.y * q.y) + (kk.z * q.z + kk.w * q.w); }
      sv[4] = (jj == 0) ? dot * 0.125f : -1e30f; mx = fmaxf(mx, sv[4]); }
#pragma unroll
    for (int o = 1; o < 32; o <<= 1) mx = fmaxf(mx, __shfl_xor(mx, o));
    float sum = 0.f;
#pragma unroll
    for (int r = 0; r < 5; ++r) { sv[r] = __builtin_amdgcn_exp2f((sv[r] - mx) * LOG2E); sum += sv[r]; }
#pragma unroll
    for (int o = 1; o < 32; o <<= 1) sum += __shfl_xor(sum, o);
    sum += __builtin_amdgcn_exp2f((sink - mx) * LOG2E);
    const float inv = 1.0f / sum;
#pragma unroll
    for (int r = 0; r < 4; ++r) sc[h * 132 + jj + 32 * r] = sv[r] * inv;
    if (jj == 0) sc[h * 132 + 128] = sv[4] * inv;
    __syncthreads();
    { const int d2 = jj * 2; float o0 = 0.f, o1 = 0.f; const float* vp = F.cv + ((size_t)b * 128 * 4 + kvh) * 64 + d2;
#pragma unroll 8
      for (int j = 0; j < 128; ++j) { const float p = sc[h * 132 + j]; const f32x2 v = *(const f32x2*)(vp + (size_t)j * 256); o0 += p * v.x; o1 += p * v.y; }
      const float p = sc[h * 132 + 128]; o0 += p * Hs[C_VA + kvh * 64 + d2]; o1 += p * Hs[C_VA + kvh * 64 + d2 + 1];
      *(unsigned*)(ABs + 1024 + h * 64 + d2) = cvt_pk_bf16(o0, o1); }
    __syncthreads();
}

#define XB_TMO      128
#define XB_XCNT(j)  (256  + 64 * (j))
#define XB_XSUB(j)  (1280 + 64 * (j))
#define XB_XGEN(j)  (2304 + 64 * (j))
#define XB_TOP      3328
#define XB_TOPGEN   3392
#define XCD_BAR_WORDS 3456
#define XB_SPIN_CAP (1u << 18)
__device__ __forceinline__ unsigned xb_ld(unsigned* p)              { return __hip_atomic_load(p, __ATOMIC_RELAXED, __HIP_MEMORY_SCOPE_AGENT); }
__device__ __forceinline__ unsigned xb_add(unsigned* p, unsigned v) { return __hip_atomic_fetch_add(p, v, __ATOMIC_RELAXED, __HIP_MEMORY_SCOPE_AGENT); }
__device__ __forceinline__ unsigned xb_xcc_id() { return (unsigned)__builtin_amdgcn_s_getreg((3 << 11) | 20) & 0xFu; }
#define XB_SPIN(cond, bar) do { unsigned _sp = 0; while (cond) { __builtin_amdgcn_s_sleep(1); \
    if ((++_sp & 255u) == 0u) { if (xb_ld(&(bar)[XB_TMO])) break; if (_sp > XB_SPIN_CAP) { atomicAdd(&(bar)[XB_TMO], 1u); break; } } } } while (0)
struct XcdBarrier { unsigned* bar; unsigned x; volatile LAS unsigned* st; };
__device__ __forceinline__ XcdBarrier xcd_barrier_post(unsigned* bar, volatile LAS unsigned* st) {
    XcdBarrier b; b.bar = bar; b.x = xb_xcc_id(); b.st = st;
    if (threadIdx.x == 0) (void)xb_add(&bar[XB_XCNT(b.x)], 1u);
    return b;
}
__device__ __forceinline__ void xcd_barrier_complete(unsigned* bar, unsigned x, unsigned& nloc, unsigned& nx) {
    const unsigned G = gridDim.x * gridDim.y * gridDim.z;
    unsigned sum, cnt, mine, sp = 0u;
    for (;;) {
        sum = 0u; cnt = 0u; mine = 0u;
#pragma unroll
        for (unsigned j = 0; j < 16; ++j) { const unsigned c = xb_ld(&bar[XB_XCNT(j)]); sum += c; cnt += (c > 0u) ? 1u : 0u; mine = (j == x) ? c : mine; }
        if (sum == G) break;
        __builtin_amdgcn_s_sleep(1);
        if ((++sp & 255u) == 0u) { if (xb_ld(&bar[XB_TMO])) break; if (sp > XB_SPIN_CAP) { atomicAdd(&bar[XB_TMO], 1u); break; } }
    }
    nloc = mine > 0u ? mine : 1u; nx = cnt > 0u ? cnt : 1u;
}
__device__ __forceinline__ void xcd_barrier(const XcdBarrier& b) {
    asm volatile("s_waitcnt vmcnt(0)" ::: "memory");
    __syncthreads();
    if (threadIdx.x == 0) {
        unsigned* bar = b.bar;
        __builtin_amdgcn_s_waitcnt(0);
        unsigned nloc = b.st[0], nx = b.st[1];
        if (nloc == 0u) { xcd_barrier_complete(bar, b.x, nloc, nx); b.st[0] = nloc; b.st[1] = nx; }
        const unsigned old = xb_add(&bar[XB_XSUB(b.x)], 1u);
        const unsigned gen = old / nloc;
        if (old + 1u == (gen + 1u) * nloc) {
            __builtin_amdgcn_fence(__ATOMIC_RELEASE, "agent");
            asm volatile("s_waitcnt vmcnt(0)" ::: "memory");
            const unsigned og = xb_add(&bar[XB_TOP], 1u);
            const unsigned tg = og / nx;
            if (og + 1u == (tg + 1u) * nx) xb_add(&bar[XB_TOPGEN], 1u);
            else XB_SPIN(xb_ld(&bar[XB_TOPGEN]) == tg, bar);
            __builtin_amdgcn_fence(__ATOMIC_ACQUIRE, "agent");
            xb_add(&bar[XB_XGEN(b.x)], 1u);
            asm volatile("s_waitcnt vmcnt(0)" ::: "memory");
        } else {
            XB_SPIN(xb_ld(&bar[XB_XGEN(b.x)]) == gen, bar);
            __builtin_amdgcn_fence(__ATOMIC_ACQUIRE, "agent");
            asm volatile("s_waitcnt vmcnt(0)" ::: "memory");
        }
    }
    __syncthreads();
}

#define PHASE_IDS const int tid_ = opaque_tid(), lane = tid_ & 63, wave = __builtin_amdgcn_readfirstlane(tid_ >> 6), l15 = lane & 15, g4 = lane >> 4; (void)l15; (void)g4; (void)wave;
__global__ void __launch_bounds__(512, 2) fwd_megakernel(Args args) {
    extern __shared__ __attribute__((aligned(16))) unsigned char lds_raw[];
    LAS unsigned char* lds = (LAS unsigned char*)lds_raw;
    cg::grid_group grid = cg::this_grid();
    Ctx F;
    F.xp = args.in[0]; F.xs = args.in[1]; F.ck = args.in[2]; F.cv = args.in[3]; F.g1 = args.in[4]; F.w_in = args.in[5]; F.gs = args.in[6]; F.sgu_w = args.in[7];
    F.sgu_b = args.in[8]; F.sinks = args.in[9]; F.w_oa = args.in[10]; F.w_ob = args.in[11]; F.w_out = args.in[12]; F.g2 = args.in[13]; F.w_up = args.in[14];
    F.w_down = args.in[15]; F.gf = args.in[16]; F.out = args.out; F.ws = args.ws;
    F.G = gridDim.x; F.bid = blockIdx.x;
    unsigned char* ws = args.ws;
    float* vss = (float*)(ws + WS_VSS); float* x1ss = (float*)(ws + WS_X1SS);
    bf16_t* H = (bf16_t*)(ws + WS_H); bf16_t* XN = (bf16_t*)(ws + WS_XN); bf16_t* T1 = (bf16_t*)(ws + WS_T1); bf16_t* X1B = (bf16_t*)(ws + WS_X1B); bf16_t* Fb = (bf16_t*)(ws + WS_F);
    bf16_t* WinT = (bf16_t*)(ws + WS_WIN); bf16_t* WoabT = (bf16_t*)(ws + WS_WOAB); bf16_t* WoutT = (bf16_t*)(ws + WS_WOUT); bf16_t* WupT = (bf16_t*)(ws + WS_WUP); bf16_t* WdownT = (bf16_t*)(ws + WS_WDOWN);
    bf16_t* XNs = (bf16_t*)(ws + WS_XNS); float* Hs = (float*)(ws + WS_HS); bf16_t* ABs = (bf16_t*)(ws + WS_ABS); bf16_t* Hgs = (bf16_t*)(ws + WS_HGS);
    float* X1s = (float*)(ws + WS_X1S); bf16_t* X1Bs = (bf16_t*)(ws + WS_X1BS); bf16_t* Fs = (bf16_t*)(ws + WS_FS); float* Ds = (float*)(ws + WS_DS);
    const bf16_t* Wt = (const bf16_t*)(ws + WS_WTRIL);
    float* y = F.out + O_YP;

    unsigned* barw = (unsigned*)(ws + WS_BAR);
    if (threadIdx.x < 4) ((LAS unsigned*)(lds + 131072 + 128))[threadIdx.x] = 0u;
    if (blockIdx.x == 0) for (int i = threadIdx.x; i < XCD_BAR_WORDS; i += 512) __hip_atomic_store(barw + i, 0u, __ATOMIC_RELAXED, __HIP_MEMORY_SCOPE_AGENT);
    __syncthreads();
    p0_prologue(F, lds);
    grid.sync();
    const XcdBarrier xb = xcd_barrier_post(barw, (volatile LAS unsigned*)(lds + 131072 + 128));

    { PHASE_IDS
    for (int it = F.bid; it < INW / 32; it += F.G) { const int n0 = it * 32; f32x4 acc[2];
        skinny_lds<2>(lds, XNs, D, WinT + (size_t)n0 * D, D, acc);
#pragma unroll
        for (int t = 0; t < 2; ++t) { const int row = 16 * wave + l15, col = n0 + 16 * t + 4 * g4; f32x4 o;
#pragma unroll
            for (int i = 0; i < 4; ++i) o[i] = act_in(acc[t][i], col);
            *(f32x4*)(Hs + (size_t)row * INW + col) = o; } } }
    { pg8::Gemm g{XN, WinT, D, D, 0, 0}; pg8::StaticOrder S; S.init(MP, INW, F.G, F.bid, 1); pg8::EpiIn E{H, vss};
      pg8::gemm_phase<pg8::EpiIn, pg8::StaticOrder, true, true>(lds, g, S, E); }
    xcd_barrier(xb);

    { PHASE_IDS const int gt = F.bid * 512 + tid_, GT = F.G * 512;
      for (int idx = gt; idx < 128 * 128 * 64; idx += GT) { const int b = idx >> 13, w = (idx >> 6) & 127, c4 = idx & 63;
          f32x4 kv, vv;
          if (w < 127) { kv = *(const f32x4*)(F.ck + ((size_t)(b * 128 + w + 1) * 256 + c4 * 4)); vv = *(const f32x4*)(F.cv + ((size_t)(b * 128 + w + 1) * 256 + c4 * 4)); }
          else { kv = *(const f32x4*)(Hs + (size_t)b * INW + C_K + c4 * 4); vv = *(const f32x4*)(Hs + (size_t)b * INW + C_VA + c4 * 4); }
          *(f32x4*)(F.out + O_KWS + (size_t)idx * 4) = kv; *(f32x4*)(F.out + O_VWS + (size_t)idx * 4) = vv; }
      for (int idx = gt; idx < 4 * 128 * 64; idx += GT) { const int b = idx >> 13, w = (idx >> 6) & 127, c8 = idx & 63;
          const u32x4 wv = *(const u32x4*)(H + (size_t)(b * SEQ + SEQ - 128 + w) * INW + C_K + c8 * 8);
          float* op = F.out + (c8 < 32 ? O_KWP : O_VWP) + (size_t)(b * 128 + w) * 256 + (c8 & 31) * 8;
          *(f32x4*)op = (f32x4){bflo(wv.x), bfhi(wv.x), bflo(wv.y), bfhi(wv.y)}; *(f32x4*)(op + 4) = (f32x4){bflo(wv.z), bfhi(wv.z), bflo(wv.w), bfhi(wv.w)}; }
    }
    for (int it = F.bid; it < 512 + 1024 + 128; it += F.G) {
        if (it < 512) { const int qb = it & 31, kvh = (it >> 5) & 3, b = it >> 7; attn_unit(F, lds, H, b, kvh, qb); }
        else if (it < 1536) { const int r = it - 512; const int gi = r & 7, ch = (r >> 3) & 31, b = r >> 8; sgu_unit(F, lds, H, vss, Wt, b, ch, gi); }
        else sample_row(F, lds, it - 1536);
    }
    xcd_barrier(xb);

    { PHASE_IDS
    for (int it = F.bid; it < D / 16; it += F.G) { const int n0 = it * 16;
        f32x4 a1[1], b1[1]; skinny_lds<1>(lds, ABs, 2048, WoabT + (size_t)n0 * D, D, a1); skinny_lds<1>(lds, ABs + 1024, 2048, WoabT + (size_t)(1024 + n0) * D, D, b1);
        const f32x4 accA = a1[0], accB = b1[0];
        const int row = 16 * wave + l15, col = n0 + 4 * g4;
        const f32x4 ga = *(const f32x4*)(Hs + (size_t)row * INW + C_GA + col), gb = *(const f32x4*)(Hs + (size_t)row * INW + C_GB + col);
        const f32x4 hv = ga * accA + gb * accB; u32x2 w; w.x = cvt_pk_bf16(hv[0], hv[1]); w.y = cvt_pk_bf16(hv[2], hv[3]);
        *(u32x2*)(Hgs + (size_t)row * D + col) = w; } }
    __syncthreads();
    { pg8::Gemm g{H + C_U, WoabT, INW, D, (size_t)(C_Q - C_U) * 2, 4}; pg8::StaticOrder S; S.init(MP, D, F.G, F.bid, 2); pg8::EpiOab E{H, T1};
      pg8::gemm_phase<pg8::EpiOab, pg8::StaticOrder, true, true>(lds, g, S, E); }
    xcd_barrier(xb);

    { PHASE_IDS
    for (int it = F.bid; it < D / 16; it += F.G) { const int n0 = it * 16;
        f32x4 a1[1]; skinny_lds<1>(lds, Hgs, D, WoutT + (size_t)n0 * D, D, a1); const f32x4 acc = a1[0];
        const int row = 16 * wave + l15, col = n0 + 4 * g4;
        const f32x4 v = acc + *(const f32x4*)(F.xs + (size_t)row * D + col);
        *(f32x4*)(X1s + (size_t)row * D + col) = v; u32x2 w; w.x = cvt_pk_bf16(v[0], v[1]); w.y = cvt_pk_bf16(v[2], v[3]); *(u32x2*)(X1Bs + (size_t)row * D + col) = w; } }
    __syncthreads();
    { pg8::Gemm g{T1, WoutT, D, D, 0, 0}; pg8::StaticOrder S; S.init(MP, D, F.G, F.bid, 1); pg8::EpiOut E{F.xp, y, X1B, x1ss};
      pg8::gemm_phase<pg8::EpiOut, pg8::StaticOrder, true, true>(lds, g, S, E); }
    xcd_barrier(xb);

    { const int t_ = opaque_tid(); for (int row = F.bid * 512 + t_; row < MP; row += F.G * 512) { const f32x4* sp = (const f32x4*)(x1ss + (size_t)row * 16); const f32x4 s4 = (sp[0] + sp[1]) + (sp[2] + sp[3]);
        ((float*)(ws + WS_VSS))[row] = ((s4[0] + s4[1]) + (s4[2] + s4[3])) * (1.0f / D) + EPS; } }
    { PHASE_IDS
    for (int it = F.bid; it < FF / 16; it += F.G) { const int n0 = it * 16;
        f32x4 a1[1]; skinny_lds<1>(lds, X1Bs, D, WupT + (size_t)n0 * D, D, a1); const f32x4 acc = a1[0];
        const int row = 16 * wave + l15, col = n0 + 4 * g4; f32x4 v;
#pragma unroll
        for (int i = 0; i < 4; ++i) { const float a = fmaxf(acc[i], 0.f); v[i] = a * a; }
        u32x2 w; w.x = cvt_pk_bf16(v[0], v[1]); w.y = cvt_pk_bf16(v[2], v[3]); *(u32x2*)(Fs + (size_t)row * FF + col) = w; } }
    __syncthreads();
    { pg8::Gemm g{X1B, WupT, D, D, 0, 0}; pg8::StaticOrder S; S.init(MP, FF, F.G, F.bid, 1); pg8::EpiUp E{Fb};
      pg8::gemm_phase<pg8::EpiUp, pg8::StaticOrder, true, true>(lds, g, S, E); }
    xcd_barrier(xb);

    { PHASE_IDS
    for (int it = F.bid; it < 256; it += F.G) { const int n0 = (it & 63) * 16, ks = it >> 6;
        f32x4 a1[1]; skinny_lds<1>(lds, Fs + ks * 1024, FF, WdownT + (size_t)n0 * FF + ks * 1024, FF, a1); const f32x4 acc = a1[0];
        const int row = 16 * wave + l15, col = n0 + 4 * g4;
        *(f32x4*)(Ds + ((size_t)ks * NS + row) * D + col) = acc; } }
    __syncthreads();
    { pg8::Gemm g{Fb, WdownT, FF, FF, 0, 0}; pg8::StaticOrder S; S.init(MP, D, F.G, F.bid, 1); pg8::EpiDown E{y, (const float*)(ws + WS_VSS)};
      pg8::gemm_phase<pg8::EpiDown, pg8::StaticOrder, true, true>(lds, g, S, E); }
    xcd_barrier(xb);

    { PHASE_IDS const int gw = F.bid * 8 + wave, NGW = F.G * 8;
      for (int m = gw; m < MP + NS; m += NGW) {
          f32x4 v[4]; const f32x4* gr = (const f32x4*)F.gf + lane; float* orow;
          if (m < MP) { orow = y + (size_t)m * D; const f32x4* xr = (const f32x4*)orow + lane;
#pragma unroll
              for (int j = 0; j < 4; ++j) v[j] = xr[64 * j];
          } else { const int r = m - MP; orow = F.out + O_YS + (size_t)r * D; const f32x4* xr = (const f32x4*)(X1s + (size_t)r * D) + lane; float s1 = 0.f;
#pragma unroll
              for (int j = 0; j < 4; ++j) { v[j] = xr[64 * j]; s1 += (v[j].x * v[j].x + v[j].y * v[j].y) + (v[j].z * v[j].z + v[j].w * v[j].w); }
              const float r2 = 1.0f / (wave_sum(s1) * (1.0f / D) + EPS);
#pragma unroll
              for (int j = 0; j < 4; ++j) { f32x4 d = {0.f, 0.f, 0.f, 0.f};
#pragma unroll
                  for (int ks = 0; ks < 4; ++ks) d += ((const f32x4*)(Ds + ((size_t)ks * NS + r) * D) + lane)[64 * j];
                  v[j] += d * r2; }
          }
          float s = 0.f;
#pragma unroll
          for (int j = 0; j < 4; ++j) s += (v[j].x * v[j].x + v[j].y * v[j].y) + (v[j].z * v[j].z + v[j].w * v[j].w);
          const float rr = 1.0f / sqrtf(wave_sum(s) * (1.0f / D) + EPS);
#pragma unroll
          for (int j = 0; j < 4; ++j) ((f32x4*)orow + lane)[64 * j] = v[j] * rr * gr[64 * j];
      }
    }
}

extern "C" void kernel_launch(void* const* d_in, const int* in_sizes, int n_in, void* d_out, int out_size, void* d_ws, size_t ws_size, hipStream_t stream) {
    static int grid = 0;
    if (grid == 0) {
        if (n_in != 17 || in_sizes[0] != MP * D || (size_t)out_size != O_END || ws_size < WS_END) {
            fprintf(stderr, "kernel_launch: unexpected shapes: n_in %d in0 %d out %d ws %zu\n", n_in, n_in > 0 ? in_sizes[0] : -1, out_size, ws_size); grid = -1; return; }
        int dev = 0, cus = 0, per_cu = 0;
        hipGetDevice(&dev); hipDeviceGetAttribute(&cus, hipDeviceAttributeMultiprocessorCount, dev);
        if (hipFuncSetAttribute((const void*)fwd_megakernel, hipFuncAttributeMaxDynamicSharedMemorySize, LDS_BYTES) != hipSuccess) { fprintf(stderr, "kernel_launch: hipFuncSetAttribute failed\n"); grid = -1; return; }
        if (hipOccupancyMaxActiveBlocksPerMultiprocessor(&per_cu, (const void*)fwd_megakernel, 512, LDS_BYTES) != hipSuccess || per_cu < 1) { fprintf(stderr, "kernel_launch: occupancy query gave %d\n", per_cu); per_cu = 1; }
        (void)hipGetLastError();
        grid = cus * 1;
        if (grid > 256) grid = 256;
    }
    if (grid < 0) return;
    Args a{};
    for (int i = 0; i < 17; ++i) a.in[i] = (const float*)d_in[i];
    a.out = (float*)d_out; a.ws = (unsigned char*)d_ws;
    void* kargs[] = {&a};
    hipError_t e = hipLaunchCooperativeKernel((const void*)fwd_megakernel, dim3(grid), dim3(512), kargs, LDS_BYTES, stream);
    if (e != hipSuccess) fprintf(stderr, "kernel_launch: cooperative launch failed: %s (grid %d)\n", hipGetErrorString(e), grid);
}
```

```cpp
#include <hip/hip_runtime.h>
#include <hip/hip_cooperative_groups.h>
#include <cstdio>
#include <cstdint>
namespace cg = cooperative_groups;

#define LAS __attribute__((address_space(3)))
#define PG8_LAS __attribute__((address_space(3)))
typedef unsigned short bf16_t;
typedef short bf16x8 __attribute__((ext_vector_type(8)));
typedef short s16x4 __attribute__((ext_vector_type(4)));
typedef float f32x4 __attribute__((ext_vector_type(4)));
typedef float f32x2 __attribute__((ext_vector_type(2)));
typedef float f32x2_t __attribute__((ext_vector_type(2)));
typedef unsigned u32x4 __attribute__((ext_vector_type(4)));
typedef unsigned u32x2 __attribute__((ext_vector_type(2)));

constexpr int D = 1024, SEQ = 4096, NBATCH = 4, MP = NBATCH * SEQ, NS = 128, INW = 5632, FF = 4096;
constexpr int C_U = 0, C_V = 1024, C_Q = 2048, C_K = 3072, C_VA = 3328, C_GA = 3584, C_GB = 4608;
constexpr float EPS = 1e-6f;
constexpr float LOG2E = 1.4426950408889634f;
constexpr size_t O_YP = 0, O_YS = (size_t)MP * D, O_KWP = O_YS + (size_t)NS * D, O_VWP = O_KWP + 131072, O_KWS = O_VWP + 131072,
                 O_VWS = O_KWS + 4194304, O_SGV = O_VWS + 4194304, O_END = O_SGV + 131072;
constexpr size_t KiB = 1024, MiB = 1024 * 1024;
constexpr size_t WS_VSS = 0, WS_X1SS = 1 * MiB;
constexpr size_t WS_XNS = 2 * MiB, WS_HS = WS_XNS + 256 * KiB, WS_ABS = 5 * MiB, WS_HGS = WS_ABS + 512 * KiB, WS_X1S = WS_HGS + 256 * KiB,
                 WS_X1BS = WS_X1S + 512 * KiB, WS_FS = WS_X1BS + 256 * KiB, WS_DS = WS_FS + 1 * MiB, WS_WTRIL = WS_DS + 2 * MiB;
constexpr size_t WS_WIN = 10 * MiB, WS_WOAB = 21 * MiB, WS_WOUT = 25 * MiB, WS_WUP = 27 * MiB, WS_WDOWN = 35 * MiB;
constexpr size_t WS_H = 44 * MiB, WS_X1B = WS_H, WS_F = WS_H + 32 * MiB, WS_XN = 220 * MiB, WS_T1 = WS_XN, WS_END = 252 * MiB;
static_assert(WS_HS + (size_t)NS * INW * 4 <= WS_ABS && WS_WTRIL + 256 * KiB <= WS_WIN && WS_WIN + (size_t)INW * D * 2 <= WS_WOAB, "ws map");
static_assert(WS_H + (size_t)MP * INW * 2 <= WS_XN && WS_F + (size_t)MP * FF * 2 <= WS_XN, "ws map 2");
constexpr size_t WS_BAR = WS_WTRIL + 256 * KiB;
static_assert(WS_BAR + 16384 <= WS_WIN, "ws map 3");
constexpr int LDS_BYTES = 147456;

typedef __bf16 bf16x2_t __attribute__((ext_vector_type(2)));
__device__ __forceinline__ unsigned cvt_pk_bf16(float lo, float hi) { const f32x2_t v = {lo, hi}; const bf16x2_t b = __builtin_convertvector(v, bf16x2_t); return __builtin_bit_cast(unsigned, b); }
__device__ __forceinline__ float bflo(unsigned w) { return __uint_as_float(w << 16); }
__device__ __forceinline__ float bfhi(unsigned w) { return __uint_as_float(w & 0xffff0000u); }
__device__ __forceinline__ float bf1(bf16_t h) { return __uint_as_float(((unsigned)h) << 16); }
__device__ __forceinline__ float gelu_t(float x) {
    const float u = x * (1.0f + 0.044715f * x * x);
    const float e = __builtin_amdgcn_exp2f(-2.302208198f * u);
    return x * __builtin_amdgcn_rcpf(1.0f + e);
}
__device__ __forceinline__ float sigmoid_f(float x) { return __builtin_amdgcn_rcpf(1.0f + __builtin_amdgcn_exp2f(-LOG2E * x)); }
__device__ __forceinline__ int opaque_tid() { int t = threadIdx.x; asm volatile("" : "+v"(t)); return t; }
__device__ __forceinline__ float wave_sum(float v) {
#pragma unroll
    for (int o = 1; o < 64; o <<= 1) v += __shfl_xor(v, o);
    return v;
}
__device__ __forceinline__ s16x4 tr_read(const LAS bf16_t* p) {
    typedef short v4i16_t __attribute__((ext_vector_type(4)));
    return __builtin_bit_cast(s16x4, __builtin_amdgcn_ds_read_tr16_b64_v4i16((LAS v4i16_t*)p));
}

namespace pg8 {
constexpr int BM = 256, BK = 64, HALF = 128, HTB = HALF * BK * 2, STAGE_BYTES = 8 * HTB, NXCD = 8, WGM = 8;
__host__ __device__ __forceinline__ int lds_byte(int r, int c) { const int st = (r >> 4) * 2 + (c >> 5), rr = r & 15, cc = c & 31, ob = rr * 64 + cc * 2; return st * 1024 + (ob ^ (((ob >> 9) & 1) << 5)); }
__host__ __device__ __forceinline__ void stage_rc(int b, int& R, int& C) { const int st = b / 1024, sb = b % 1024, swz = sb ^ (((sb >> 9) & 1) << 5); R = (st >> 1) * 16 + swz / 64; C = (st & 1) * 32 + (swz % 64) / 2; }
__host__ __device__ __forceinline__ int perm32(int rho) { const int n = rho >> 4, i = rho & 15; return 8 * (i >> 2) + 4 * n + (i & 3); }

struct Unit { int pm, pn, sub; };
struct Gemm { const bf16_t* A; const bf16_t* Bt; int lda, K; size_t a_sub_off; int b_sub_tiles; };

struct StaticOrder {
    int nM, nN, nwg, G, c, nsub;
    __host__ __device__ void init(int M, int N, int G_, int c_, int nsub_) { nM = M / BM; nN = N / BM; nwg = nM * nN; G = G_; c = c_; nsub = nsub_; }
    __host__ __device__ bool next(int i, Unit& u) const {
        const int j = i / nsub; u.sub = i - j * nsub;
        const long L = (long)j * G + c; if (L >= nwg) return false;
        int wgid = (int)L; { const int q = nwg / NXCD, r = nwg % NXCD, xcd = wgid % NXCD, off = wgid / NXCD; wgid = (xcd < r ? xcd * (q + 1) : r * (q + 1) + (xcd - r) * q) + off; }
        const int nig = WGM * nN, gid = wgid / nig, fm = gid * WGM, gsz = (nM - fm) < WGM ? (nM - fm) : WGM;
        u.pm = fm + ((wgid % nig) % gsz); u.pn = (wgid % nig) / gsz; return true;
    }
    __device__ __forceinline__ void a_ready(const Unit&) const {}
    __device__ __forceinline__ void done(const Unit&) const {}
};

__device__ __forceinline__ u32x4 pack8(const f32x4 v0, const f32x4 v1) { u32x4 w; w.x = cvt_pk_bf16(v0[0], v0[1]); w.y = cvt_pk_bf16(v0[2], v0[3]); w.z = cvt_pk_bf16(v1[0], v1[1]); w.w = cvt_pk_bf16(v1[2], v1[3]); return w; }

struct EpiIn {
    static constexpr bool PERM = true, AFTER_DRAIN = false, HAS_INIT = false;
    bf16_t* H; float* vss;
    __device__ __forceinline__ void operator()(const f32x4 (&acc)[2][2][4][2], const Unit& u, int wr, int wc, int fr, int fq) const {
        const int pn = u.pn; const int mode = pn < 8 ? 1 : (pn < 14 ? 0 : 2); const bool isv = (pn >= 4 && pn < 8);
        const int row0 = u.pm * BM + wr * 64 + fr, col0 = pn * BM + wc * 32 + 8 * fq;
#pragma unroll
        for (int ai = 0; ai < 2; ++ai)
#pragma unroll
            for (int m = 0; m < 4; ++m) { const int row = row0 + ai * HALF + m * 16; bf16_t* rowp = H + (size_t)row * INW + col0; float ss = 0.f;
#pragma unroll
                for (int bj = 0; bj < 2; ++bj) { f32x4 v0 = acc[ai][bj][m][0], v1 = acc[ai][bj][m][1];
                    if (mode == 1) {
#pragma unroll
                        for (int e = 0; e < 4; ++e) { v0[e] = gelu_t(v0[e]); v1[e] = gelu_t(v1[e]); }
                        if (isv) {
#pragma unroll
                            for (int e = 0; e < 4; ++e) ss += v0[e] * v0[e] + v1[e] * v1[e]; }
                    } else if (mode == 2) {
#pragma unroll
                        for (int e = 0; e < 4; ++e) { v0[e] = sigmoid_f(v0[e]); v1[e] = sigmoid_f(v1[e]); }
                    }
                    *(u32x4*)(rowp + bj * HALF) = pack8(v0, v1); }
                if (isv) { ss += __shfl_xor(ss, 16); ss += __shfl_xor(ss, 32); if (fq == 0) vss[(size_t)row * 16 + (pn - 4) * 4 + wc] = ss; }
            }
    }
};
struct EpiOab {
    static constexpr bool PERM = true, AFTER_DRAIN = false, HAS_INIT = false;
    const bf16_t* __restrict__ H; bf16_t* __restrict__ T1;
    __device__ __forceinline__ void operator()(const f32x4 (&acc)[2][2][4][2], const Unit& u, int wr, int wc, int fr, int fq) const {
        const int row0 = u.pm * BM + wr * 64 + fr, col0 = u.pn * BM + wc * 32 + 8 * fq; const int gcol = C_GA + u.sub * 1024 + col0; const bool second = u.sub != 0;
#pragma unroll
        for (int aim = 0; aim < 4; ++aim) { const int ai = aim >> 1, mb = (aim & 1) * 2;
            u32x4 gw[4][2], tw[4][2];
#pragma unroll
            for (int m = mb; m < mb + 2; ++m)
#pragma unroll
                for (int bj = 0; bj < 2; ++bj) { const int row = row0 + ai * HALF + m * 16;
                    gw[m][bj] = *(const u32x4*)(H + (size_t)row * INW + gcol + bj * HALF);
                    if (second) tw[m][bj] = *(const u32x4*)(T1 + (size_t)row * D + col0 + bj * HALF); else tw[m][bj] = (u32x4){0u, 0u, 0u, 0u}; }
#pragma unroll
            for (int m = mb; m < mb + 2; ++m)
#pragma unroll
                for (int bj = 0; bj < 2; ++bj) { const int row = row0 + ai * HALF + m * 16;
                    const u32x4 g = gw[m][bj], t = tw[m][bj]; f32x4 v0 = acc[ai][bj][m][0], v1 = acc[ai][bj][m][1];
                    v0[0] = v0[0] * bflo(g.x) + bflo(t.x); v0[1] = v0[1] * bfhi(g.x) + bfhi(t.x); v0[2] = v0[2] * bflo(g.y) + bflo(t.y); v0[3] = v0[3] * bfhi(g.y) + bfhi(t.y);
                    v1[0] = v1[0] * bflo(g.z) + bflo(t.z); v1[1] = v1[1] * bfhi(g.z) + bfhi(t.z); v1[2] = v1[2] * bflo(g.w) + bflo(t.w); v1[3] = v1[3] * bfhi(g.w) + bfhi(t.w);
                    *(u32x4*)(T1 + (size_t)row * D + col0 + bj * HALF) = pack8(v0, v1); }
        }
    }
};
struct EpiOut {
    static constexpr bool PERM = true, AFTER_DRAIN = false, HAS_INIT = true;
    const float* x; float* y; bf16_t* X1B; float* x1ss;
    __device__ __forceinline__ void init(f32x4 (&acc)[2][2][4][2], const Unit& u, int wr, int wc, int fr, int fq) const {
        const int row0 = u.pm * BM + wr * 64 + fr, col0 = u.pn * BM + wc * 32 + 8 * fq;
#pragma unroll
        for (int ai = 0; ai < 2; ++ai)
#pragma unroll
            for (int m = 0; m < 4; ++m)
#pragma unroll
                for (int bj = 0; bj < 2; ++bj) { const size_t off = (size_t)(row0 + ai * HALF + m * 16) * D + col0 + bj * HALF;
                    acc[ai][bj][m][0] = *(const f32x4*)(x + off); acc[ai][bj][m][1] = *(const f32x4*)(x + off + 4); }
    }
    __device__ __forceinline__ void operator()(const f32x4 (&acc)[2][2][4][2], const Unit& u, int wr, int wc, int fr, int fq) const {
        const int row0 = u.pm * BM + wr * 64 + fr, col0 = u.pn * BM + wc * 32 + 8 * fq;
#pragma unroll
        for (int ai = 0; ai < 2; ++ai)
#pragma unroll
            for (int m = 0; m < 4; ++m) { const int row = row0 + ai * HALF + m * 16; float ss = 0.f;
#pragma unroll
                for (int bj = 0; bj < 2; ++bj) { const size_t off = (size_t)row * D + col0 + bj * HALF;
                    const f32x4 v0 = acc[ai][bj][m][0], v1 = acc[ai][bj][m][1];
                    *(f32x4*)(y + off) = v0; *(f32x4*)(y + off + 4) = v1; *(u32x4*)(X1B + off) = pack8(v0, v1);
#pragma unroll
                    for (int e = 0; e < 4; ++e) ss += v0[e] * v0[e] + v1[e] * v1[e]; }
                ss += __shfl_xor(ss, 16); ss += __shfl_xor(ss, 32); if (fq == 0) x1ss[(size_t)row * 16 + u.pn * 4 + wc] = ss;
            }
    }
};
struct EpiUp {
    static constexpr bool PERM = true, AFTER_DRAIN = false, HAS_INIT = false;
    bf16_t* F;
    __device__ __forceinline__ void operator()(const f32x4 (&acc)[2][2][4][2], const Unit& u, int wr, int wc, int fr, int fq) const {
        const int row0 = u.pm * BM + wr * 64 + fr, col0 = u.pn * BM + wc * 32 + 8 * fq;
#pragma unroll
        for (int ai = 0; ai < 2; ++ai)
#pragma unroll
            for (int m = 0; m < 4; ++m) { const int row = row0 + ai * HALF + m * 16;
#pragma unroll
                for (int bj = 0; bj < 2; ++bj) { f32x4 v0 = acc[ai][bj][m][0], v1 = acc[ai][bj][m][1];
#pragma unroll
                    for (int e = 0; e < 4; ++e) { const float a = fmaxf(v0[e], 0.f), b = fmaxf(v1[e], 0.f); v0[e] = a * a; v1[e] = b * b; }
                    *(u32x4*)(F + (size_t)row * FF + col0 + bj * HALF) = pack8(v0, v1); }
            }
    }
};
struct EpiDown {
    static constexpr bool PERM = true, AFTER_DRAIN = false, HAS_INIT = true;
    float* y; const float* x1q;
    __device__ __forceinline__ float ms_eps(int row) const { return x1q[row]; }
    __device__ __forceinline__ void init(f32x4 (&acc)[2][2][4][2], const Unit& u, int wr, int wc, int fr, int fq) const {
        const int row0 = u.pm * BM + wr * 64 + fr, col0 = u.pn * BM + wc * 32 + 8 * fq;
#pragma unroll
        for (int ai = 0; ai < 2; ++ai)
#pragma unroll
            for (int m = 0; m < 4; ++m) { const int row = row0 + ai * HALF + m * 16; const float q = ms_eps(row);
#pragma unroll
                for (int bj = 0; bj < 2; ++bj) { const size_t off = (size_t)row * D + col0 + bj * HALF;
                    acc[ai][bj][m][0] = *(const f32x4*)(y + off) * q; acc[ai][bj][m][1] = *(const f32x4*)(y + off + 4) * q; } }
    }
    __device__ __forceinline__ void operator()(const f32x4 (&acc)[2][2][4][2], const Unit& u, int wr, int wc, int fr, int fq) const {
        const int row0 = u.pm * BM + wr * 64 + fr, col0 = u.pn * BM + wc * 32 + 8 * fq;
#pragma unroll
        for (int ai = 0; ai < 2; ++ai)
#pragma unroll
            for (int m = 0; m < 4; ++m) { const int row = row0 + ai * HALF + m * 16; const float r2 = 1.0f / ms_eps(row);
#pragma unroll
                for (int bj = 0; bj < 2; ++bj) { const size_t off = (size_t)row * D + col0 + bj * HALF;
                    *(f32x4*)(y + off) = acc[ai][bj][m][0] * r2; *(f32x4*)(y + off + 4) = acc[ai][bj][m][1] * r2; }
            }
    }
};

template <class Epi, class Sched, bool ALIGN_EPI = false, bool SP2 = false>
__device__ __forceinline__ void gemm_phase(PG8_LAS unsigned char* lds, const Gemm g, const Sched& S, const Epi& E) {
    const int tid = opaque_tid(), wid = __builtin_amdgcn_readfirstlane(tid >> 6), lane = tid & 63, wr = wid >> 2, wc = wid & 3, fr = lane & 15, fq = lane >> 4;
    const int K = g.K, nt = K / BK;
    unsigned voffA[2], voffB[2];
#pragma unroll
    for (int i = 0; i < 2; ++i) { int R, C; stage_rc(tid * 16 + i * 8192, R, C); const int Rb = Epi::PERM ? ((R & ~31) + perm32(R & 31)) : R;
        voffA[i] = (unsigned)(R * g.lda + C) * 2u; voffB[i] = (unsigned)(Rb * K + C) * 2u; }
    const size_t kstep = (size_t)(BK * 2);
    const size_t hstepA = (size_t)HALF * g.lda * 2, hstepB = (size_t)HALF * K * 2;
    const size_t tstepA = 2 * hstepA, tstepB = 2 * hstepB;
    const unsigned ldsw = (unsigned)wid * 1024u;
    const int aoff = lds_byte(wr * 64 + fr, fq * 8), boff = lds_byte(wc * 32 + fr, fq * 8);
#define PG8_SA(b, h) (((b) * 2 + (h)) * HTB)
#define PG8_SB(b, h) ((4 + (b) * 2 + (h)) * HTB)
#define PG8_STAGE(bufoff, gbase, voff) do { _Pragma("unroll") for (int _i = 0; _i < 2; ++_i) \
        __builtin_amdgcn_global_load_lds((const unsigned*)((const char*)(gbase) + (voff)[_i]), (PG8_LAS unsigned*)(lds + (bufoff) + ldsw + _i * 8192), 16, 0, 0); } while (0)
#define PG8_LDA(dst, b, h) do { _Pragma("unroll") for (int m = 0; m < 4; ++m) _Pragma("unroll") for (int k = 0; k < 2; ++k) dst[m][k] = *(const PG8_LAS bf16x8*)(lds + PG8_SA(b, h) + aoff + m * 2048 + k * 1024); } while (0)
#define PG8_LDB(dst, b, h) do { _Pragma("unroll") for (int n = 0; n < 2; ++n) _Pragma("unroll") for (int k = 0; k < 2; ++k) dst[n][k] = *(const PG8_LAS bf16x8*)(lds + PG8_SB(b, h) + boff + n * 2048 + k * 1024); } while (0)
#define PG8_MMA(ai, bj, At, Bt) do { __builtin_amdgcn_s_setprio(1); _Pragma("unroll") for (int m = 0; m < 4; ++m) _Pragma("unroll") for (int n = 0; n < 2; ++n) _Pragma("unroll") for (int k = 0; k < 2; ++k) \
        acc[ai][bj][m][n] = __builtin_amdgcn_mfma_f32_16x16x32_bf16(Bt[n][k], At[m][k], acc[ai][bj][m][n], 0, 0, 0); __builtin_amdgcn_s_setprio(0); } while (0)
#define PG8_WAIT_V(n) asm volatile("s_waitcnt vmcnt(" #n ")" ::: "memory")
#define PG8_WAIT_L(n) asm volatile("s_waitcnt lgkmcnt(" #n ")" ::: "memory")
#define PG8_BAR __builtin_amdgcn_s_barrier()
#define PG8_SCHED __builtin_amdgcn_sched_barrier(0)
    Unit cur, nxt; int ui = 0;
    if (!S.next(0, cur)) return;
    f32x4 acc[2][2][4][2];
    if constexpr (Epi::HAS_INIT) { E.init(acc, cur, wr, wc, fr, fq); } else {
#pragma unroll
    for (int a = 0; a < 2; ++a)
#pragma unroll
        for (int b = 0; b < 2; ++b)
#pragma unroll
            for (int m = 0; m < 4; ++m)
#pragma unroll
                for (int n = 0; n < 2; ++n) acc[a][b][m][n] = (f32x4){0.f, 0.f, 0.f, 0.f};
    }
    bf16x8 At[4][2], B0[2][2], B1[2][2];
    const char* cA = (const char*)g.A + (size_t)cur.pm * tstepA + (size_t)cur.sub * g.a_sub_off; const char* cB = (const char*)g.Bt + (size_t)(cur.pn + cur.sub * g.b_sub_tiles) * tstepB;
    S.a_ready(cur);
    if constexpr (SP2) {
        PG8_STAGE(PG8_SB(0, 0), cB, voffB); PG8_STAGE(PG8_SB(0, 1), cB + hstepB, voffB); PG8_STAGE(PG8_SA(0, 0), cA, voffA); PG8_STAGE(PG8_SA(0, 1), cA + hstepA, voffA);
        if (wr == 1) PG8_BAR;
        PG8_WAIT_V(2); PG8_BAR;
        PG8_STAGE(PG8_SB(1, 0), cB + kstep, voffB); PG8_STAGE(PG8_SA(1, 0), cA + kstep, voffA); PG8_STAGE(PG8_SB(1, 1), cB + hstepB + kstep, voffB);
        PG8_WAIT_V(6); PG8_BAR;
    } else {
        PG8_STAGE(PG8_SB(0, 0), cB, voffB); PG8_STAGE(PG8_SA(0, 0), cA, voffA); PG8_STAGE(PG8_SB(0, 1), cB + hstepB, voffB); PG8_STAGE(PG8_SA(0, 1), cA + hstepA, voffA);
        if (wr == 1) PG8_BAR;
        PG8_WAIT_V(4); PG8_BAR;
        PG8_STAGE(PG8_SB(1, 0), cB + kstep, voffB); PG8_STAGE(PG8_SA(1, 0), cA + kstep, voffA); PG8_STAGE(PG8_SB(1, 1), cB + hstepB + kstep, voffB);
        PG8_WAIT_V(6); PG8_BAR;
    }
    for (;;) {
        const bool has_next = S.next(ui + 1, nxt);
        const char* nA = has_next ? (const char*)g.A + (size_t)nxt.pm * tstepA + (size_t)nxt.sub * g.a_sub_off : cA; const char* nB = has_next ? (const char*)g.Bt + (size_t)(nxt.pn + nxt.sub * g.b_sub_tiles) * tstepB : cB;
        for (int t = 0; t < nt; t += 2) {
            const bool last = (t == nt - 2);
            const char* a1 = cA + (size_t)(t + 1) * kstep;
            const char* a2 = last ? nA : cA + (size_t)(t + 2) * kstep; const char* b2 = last ? nB : cB + (size_t)(t + 2) * kstep;
            const char* a3 = a2 + kstep; const char* b3 = b2 + kstep;
            if (last && has_next) S.a_ready(nxt);
            if constexpr (SP2) {
            PG8_LDB(B0, 0, 0); PG8_LDB(B1, 0, 1); PG8_SCHED; PG8_LDA(At, 0, 0); PG8_STAGE(PG8_SA(1, 1), a1 + hstepA, voffA);
            PG8_WAIT_V(8); PG8_WAIT_L(0); PG8_BAR; PG8_MMA(0, 0, At, B0); PG8_MMA(0, 1, At, B1); PG8_BAR; PG8_SCHED;
            PG8_LDA(At, 0, 1); PG8_STAGE(PG8_SB(0, 0), b2, voffB); PG8_STAGE(PG8_SB(0, 1), b2 + hstepB, voffB); PG8_STAGE(PG8_SA(0, 0), a2, voffA);
            PG8_WAIT_V(8); PG8_WAIT_L(0); PG8_BAR; PG8_MMA(1, 0, At, B0); PG8_MMA(1, 1, At, B1); PG8_BAR; PG8_SCHED;
            PG8_LDB(B0, 1, 0); PG8_LDB(B1, 1, 1); PG8_SCHED; PG8_LDA(At, 1, 0); PG8_STAGE(PG8_SA(0, 1), a2 + hstepA, voffA);
            PG8_WAIT_V(8); PG8_WAIT_L(0); PG8_BAR; PG8_MMA(0, 0, At, B0); PG8_MMA(0, 1, At, B1); PG8_BAR; PG8_SCHED;
            PG8_LDA(At, 1, 1); PG8_STAGE(PG8_SB(1, 0), b3, voffB); PG8_STAGE(PG8_SB(1, 1), b3 + hstepB, voffB); PG8_STAGE(PG8_SA(1, 0), a3, voffA);
            PG8_WAIT_V(8); PG8_WAIT_L(0); PG8_BAR; PG8_MMA(1, 0, At, B0); PG8_MMA(1, 1, At, B1); PG8_BAR; PG8_SCHED;
            } else {
            PG8_LDB(B0, 0, 0); PG8_SCHED; PG8_LDA(At, 0, 0); PG8_STAGE(PG8_SA(1, 1), a1 + hstepA, voffA);
            PG8_WAIT_L(8); PG8_BAR; PG8_WAIT_L(0); PG8_MMA(0, 0, At, B0); PG8_BAR; PG8_SCHED;
            PG8_LDB(B1, 0, 1); PG8_STAGE(PG8_SB(0, 0), b2, voffB);
            PG8_BAR; PG8_WAIT_L(0); PG8_MMA(0, 1, At, B1); PG8_BAR;
            PG8_LDA(At, 0, 1); PG8_STAGE(PG8_SA(0, 0), a2, voffA);
            PG8_BAR; PG8_WAIT_L(0); PG8_MMA(1, 0, At, B0); PG8_BAR; PG8_SCHED;
            PG8_STAGE(PG8_SB(0, 1), b2 + hstepB, voffB);
            PG8_WAIT_V(6); PG8_BAR; PG8_MMA(1, 1, At, B1); PG8_BAR;
            PG8_LDB(B0, 1, 0); PG8_SCHED; PG8_LDA(At, 1, 0); PG8_STAGE(PG8_SA(0, 1), a2 + hstepA, voffA);
            PG8_WAIT_L(8); PG8_BAR; PG8_WAIT_L(0); PG8_MMA(0, 0, At, B0); PG8_BAR; PG8_SCHED;
            PG8_LDB(B1, 1, 1); PG8_STAGE(PG8_SB(1, 0), b3, voffB);
            PG8_BAR; PG8_WAIT_L(0); PG8_MMA(0, 1, At, B1); PG8_BAR;
            PG8_LDA(At, 1, 1); PG8_STAGE(PG8_SA(1, 0), a3, voffA);
            PG8_BAR; PG8_WAIT_L(0); PG8_MMA(1, 0, At, B0); PG8_BAR; PG8_SCHED;
            PG8_STAGE(PG8_SB(1, 1), b3 + hstepB, voffB);
            PG8_WAIT_V(6); PG8_BAR; PG8_MMA(1, 1, At, B1); PG8_BAR;
            }
        }
        if constexpr (ALIGN_EPI) { if (wr == 0) PG8_BAR; }
        if constexpr (!Epi::AFTER_DRAIN) { E(acc, cur, wr, wc, fr, fq); S.done(cur); }
        if (!has_next) break;
        if constexpr (Epi::HAS_INIT) { E.init(acc, nxt, wr, wc, fr, fq); } else {
#pragma unroll
        for (int a = 0; a < 2; ++a)
#pragma unroll
            for (int b = 0; b < 2; ++b)
#pragma unroll
                for (int m = 0; m < 4; ++m)
#pragma unroll
                    for (int n = 0; n < 2; ++n) acc[a][b][m][n] = (f32x4){0.f, 0.f, 0.f, 0.f};
        }
        cur = nxt; cA = nA; cB = nB; ++ui;
        if constexpr (ALIGN_EPI) { if (wr == 1) PG8_BAR; }
    }
    PG8_WAIT_V(0);
    if constexpr (!ALIGN_EPI) { if (wr == 0) PG8_BAR; }
    PG8_BAR;
    if constexpr (Epi::AFTER_DRAIN) { E.fused(acc, cur, wr, wc, fr, fq, lds, wid, lane); S.done(cur); }
#undef PG8_SA
#undef PG8_SB
#undef PG8_STAGE
#undef PG8_LDA
#undef PG8_LDB
#undef PG8_MMA
#undef PG8_WAIT_V
#undef PG8_WAIT_L
#undef PG8_BAR
#undef PG8_SCHED
}

}

struct Args { const float* in[17]; float* out; unsigned char* ws; };
struct Ctx {
    const float *xp, *xs, *ck, *cv, *g1, *w_in, *gs, *sgu_w, *sgu_b, *sinks, *w_oa, *w_ob, *w_out, *g2, *w_up, *w_down, *gf;
    float* out; unsigned char* ws;
    int G, bid;
};
#define MFMA16(a, b, c) __builtin_amdgcn_mfma_f32_16x16x32_bf16((a), (b), (c), 0, 0, 0)

__device__ __forceinline__ void p0_transpose_item(const float* W, int K, int N, bf16_t* WT, int row_off, const float* kscale, LAS float* scr, int item, int lane) {
    const int nblk = N / 64, kb = item / nblk, nb = item - kb * nblk, k0 = 64 * kb, n0 = 64 * nb;
    const int kr = lane >> 4, c4 = lane & 15;
    f32x4 v[16];
#pragma unroll
    for (int i = 0; i < 16; ++i) v[i] = *(const f32x4*)(W + (size_t)(k0 + 4 * i + kr) * N + n0 + 4 * c4);
    if (kscale) {
#pragma unroll
        for (int i = 0; i < 16; ++i) v[i] *= kscale[k0 + 4 * i + kr]; }
#pragma unroll
    for (int i = 0; i < 16; ++i) { LAS float* s = scr + (4 * i + kr) * 65 + 4 * c4; s[0] = v[i].x; s[1] = v[i].y; s[2] = v[i].z; s[3] = v[i].w; }
    asm volatile("s_waitcnt lgkmcnt(0)" ::: "memory");
    const int c = lane & 7, nl = lane >> 3;
#pragma unroll
    for (int j = 0; j < 8; ++j) { const int n = nl + 8 * j; const LAS float* s = scr + (8 * c) * 65 + n;
        u32x4 o; o.x = cvt_pk_bf16(s[0 * 65], s[1 * 65]); o.y = cvt_pk_bf16(s[2 * 65], s[3 * 65]); o.z = cvt_pk_bf16(s[4 * 65], s[5 * 65]); o.w = cvt_pk_bf16(s[6 * 65], s[7 * 65]);
        *(u32x4*)(WT + (size_t)(row_off + n0 + n) * K + k0 + 8 * c) = o; }
    asm volatile("s_waitcnt lgkmcnt(0)" ::: "memory");
}
template <int NR> __device__ __forceinline__ void rms_rows_to_bf16(const float* xrow, const float* g, bf16_t* orow, int lane) {
    f32x4 v[NR][4]; const f32x4* gr = (const f32x4*)g + lane;
#pragma unroll
    for (int r = 0; r < NR; ++r)
#pragma unroll
        for (int j = 0; j < 4; ++j) v[r][j] = ((const f32x4*)(xrow + (size_t)r * D) + lane)[64 * j];
    f32x4 gg[4];
#pragma unroll
    for (int j = 0; j < 4; ++j) gg[j] = gr[64 * j];
#pragma unroll
    for (int r = 0; r < NR; ++r) { float s = 0.f;
#pragma unroll
        for (int j = 0; j < 4; ++j) s += (v[r][j].x * v[r][j].x + v[r][j].y * v[r][j].y) + (v[r][j].z * v[r][j].z + v[r][j].w * v[r][j].w);
        const float rr = 1.0f / sqrtf(wave_sum(s) * (1.0f / D) + EPS);
        u32x2* o8 = (u32x2*)(orow + (size_t)r * D) + lane;
#pragma unroll
        for (int j = 0; j < 4; ++j) { u32x2 w; w.x = cvt_pk_bf16(v[r][j].x * rr * gg[j].x, v[r][j].y * rr * gg[j].y); w.y = cvt_pk_bf16(v[r][j].z * rr * gg[j].z, v[r][j].w * rr * gg[j].w); o8[64 * j] = w; } }
}
__device__ __forceinline__ void p0_prologue(const Ctx& F, LAS unsigned char* lds) {
    const int tid_ = opaque_tid(), lane_ = tid_ & 63, wave_ = __builtin_amdgcn_readfirstlane(tid_ >> 6);
    LAS float* scr = (LAS float*)(lds + wave_ * 16640);
    const int gw = F.bid * 8 + wave_, NGW = F.G * 8;
    constexpr int I_IN = (D / 64) * (INW / 64), I_D = (D / 64) * (D / 64), I_UP = (D / 64) * (FF / 64), I_DN = (FF / 64) * (D / 64);
    constexpr int NITEMS = I_IN + 3 * I_D + I_UP + I_DN;
    bf16_t* WinT = (bf16_t*)(F.ws + WS_WIN); bf16_t* WoabT = (bf16_t*)(F.ws + WS_WOAB); bf16_t* WoutT = (bf16_t*)(F.ws + WS_WOUT);
    bf16_t* WupT = (bf16_t*)(F.ws + WS_WUP); bf16_t* WdownT = (bf16_t*)(F.ws + WS_WDOWN);
    const int nfull = (NITEMS / NGW) * NGW;
    for (int rnd = 0; ; ++rnd) {
        int it = rnd * NGW + gw;
        if (it >= nfull) { const int rem = NITEMS - nfull; if (it >= nfull + NGW || rem == 0) break; const int step = NGW / rem; if (gw % step != 0 || gw / step >= rem) break; it = nfull + gw / step; }
        int r = it;
        if (r < I_IN) { p0_transpose_item(F.w_in, D, INW, WinT, 0, nullptr, scr, r, lane_); continue; } r -= I_IN;
        if (r < I_D) { p0_transpose_item(F.w_oa, D, D, WoabT, 0, nullptr, scr, r, lane_); continue; } r -= I_D;
        if (r < I_D) { p0_transpose_item(F.w_ob, D, D, WoabT, D, nullptr, scr, r, lane_); continue; } r -= I_D;
        if (r < I_D) { p0_transpose_item(F.w_out, D, D, WoutT, 0, nullptr, scr, r, lane_); continue; } r -= I_D;
        if (r < I_UP) { p0_transpose_item(F.w_up, D, FF, WupT, 0, F.g2, scr, r, lane_); continue; } r -= I_UP;
        p0_transpose_item(F.w_down, FF, D, WdownT, 0, nullptr, scr, r, lane_);
    }
    bf16_t* XN = (bf16_t*)(F.ws + WS_XN); bf16_t* XNs = (bf16_t*)(F.ws + WS_XNS);
    for (int m = gw * 4; m < MP; m += NGW * 4) rms_rows_to_bf16<4>(F.xp + (size_t)m * D, F.g1, XN + (size_t)m * D, lane_);
    for (int m = NGW - 1 - gw; m < NS; m += NGW) rms_rows_to_bf16<1>(F.xs + (size_t)m * D, F.g1, XNs + (size_t)m * D, lane_);
    bf16_t* Wt = (bf16_t*)(F.ws + WS_WTRIL);
    for (int i = F.bid * 512 + tid_; i < 8 * 128 * 128; i += F.G * 512) { const int t = (i >> 7) & 127, s = i & 127; const float v = (s <= t) ? F.sgu_w[i] : 0.f; Wt[i] = (bf16_t)(cvt_pk_bf16(v, 0.f) & 0xffffu); }
    { const int gt = F.bid * 512 + tid_, GT = F.G * 512;
      for (int idx = gt; idx < 128 * 127 * 64; idx += GT) { const int c4 = idx & 63, bw = idx >> 6, b = bw / 127, w = bw - b * 127;
          const size_t so = ((size_t)(b * 128 + w + 1) * 256 + c4 * 4), dof = ((size_t)(b * 128 + w) * 256 + c4 * 4);
          const f32x4 kv = *(const f32x4*)(F.ck + so), vv = *(const f32x4*)(F.cv + so);
          *(f32x4*)(F.out + O_KWS + dof) = kv; *(f32x4*)(F.out + O_VWS + dof) = vv; } }
}

constexpr int SKP = 264;
template <int NT> __device__ __forceinline__ void skinny_lds(LAS unsigned char* lds, const bf16_t* A, int lda, const bf16_t* Bt, int ldb, f32x4 (&acc)[NT]) {
    const int tid = opaque_tid(), lane = tid & 63, wave = __builtin_amdgcn_readfirstlane(tid >> 6), l15 = lane & 15, g = lane >> 4;
    LAS bf16_t* Ai = (LAS bf16_t*)lds; LAS bf16_t* Bi = (LAS bf16_t*)(lds + 128 * SKP * 2);
    const int prow = tid >> 5, pc = tid & 31;
    const bf16_t* ag = A + (size_t)prow * lda + pc * 8; const bf16_t* bg = Bt + (size_t)prow * ldb + pc * 8;
    u32x4 ra[8], rb[NT];
#pragma unroll
    for (int i = 0; i < 8; ++i) ra[i] = *(const u32x4*)(ag + (size_t)(16 * i) * lda);
#pragma unroll
    for (int i = 0; i < NT; ++i) rb[i] = *(const u32x4*)(bg + (size_t)(16 * i) * ldb);
#pragma unroll
    for (int t = 0; t < NT; ++t) acc[t] = (f32x4){0.f, 0.f, 0.f, 0.f};
    for (int c = 0; c < 4; ++c) {
#pragma unroll
        for (int i = 0; i < 8; ++i) *(LAS u32x4*)(Ai + (prow + 16 * i) * SKP + pc * 8) = ra[i];
#pragma unroll
        for (int i = 0; i < NT; ++i) *(LAS u32x4*)(Bi + (prow + 16 * i) * SKP + pc * 8) = rb[i];
        __syncthreads();
        if (c < 3) {
#pragma unroll
            for (int i = 0; i < 8; ++i) ra[i] = *(const u32x4*)(ag + (size_t)(16 * i) * lda + 256 * (c + 1));
#pragma unroll
            for (int i = 0; i < NT; ++i) rb[i] = *(const u32x4*)(bg + (size_t)(16 * i) * ldb + 256 * (c + 1));
        }
        const LAS bf16_t* ar = Ai + (16 * wave + l15) * SKP + 8 * g; const LAS bf16_t* br = Bi + l15 * SKP + 8 * g;
#pragma unroll
        for (int ks = 0; ks < 8; ++ks) { const bf16x8 a = *(const LAS bf16x8*)(ar + 32 * ks);
#pragma unroll
            for (int t = 0; t < NT; ++t) { const bf16x8 b = *(const LAS bf16x8*)(br + 16 * t * SKP + 32 * ks); acc[t] = MFMA16(b, a, acc[t]); } }
        __syncthreads();
    }
}
__device__ __forceinline__ float act_in(float v, int col) { return col < C_Q ? gelu_t(v) : (col < C_GA ? v : sigmoid_f(v)); }

constexpr int KP = 72;
__device__ __forceinline__ void attn_unit(const Ctx& F, LAS unsigned char* lds, bf16_t* H, int b, int kvh, int qb) {
    const int tid_ = opaque_tid(), lane_ = tid_ & 63, wave_ = __builtin_amdgcn_readfirstlane(tid_ >> 6);
    LAS bf16_t* Ks = (LAS bf16_t*)lds; LAS bf16_t* Vs = (LAS bf16_t*)(lds + 256 * KP * 2);
    const int tid = tid_, lane = lane_, l15 = lane & 15, g = lane >> 4, qt = wave_;
    const long rowbase = (long)b * SEQ + (long)(qb - 1) * 128;
    bf16_t* qbase = H + (size_t)(b * SEQ + qb * 128 + 16 * qt + l15) * INW + C_Q + kvh * 256 + 8 * g;
    u32x4 kvr[4], vvr[4]; bf16x8 qf[4][2];
#pragma unroll
    for (int i = 0; i < 4; ++i) { const int c = tid + 512 * i, j = c >> 3, ch = c & 7;
        kvr[i] = (u32x4){0u, 0u, 0u, 0u}; vvr[i] = (u32x4){0u, 0u, 0u, 0u};
        if (qb > 0 || j >= 128) { const bf16_t* p = H + (size_t)(rowbase + j) * INW + C_K + kvh * 64 + ch * 8; kvr[i] = *(const u32x4*)p; vvr[i] = *(const u32x4*)(p + 256); } }
#pragma unroll
    for (int hh = 0; hh < 4; ++hh) { qf[hh][0] = *(const bf16x8*)(qbase + hh * 64); qf[hh][1] = *(const bf16x8*)(qbase + hh * 64 + 32); }
#pragma unroll
    for (int i = 0; i < 4; ++i) { const int c = tid + 512 * i, j = c >> 3, ch = c & 7;
        *(LAS u32x4*)(Ks + j * KP + ch * 8) = kvr[i]; *(LAS u32x4*)(Vs + j * KP + ch * 8) = vvr[i]; }
    if (tid < 128) *(LAS u32x4*)(Vs + (256 + (tid >> 3)) * KP + (tid & 7) * 8) = (u32x4){0u, 0u, 0u, 0u};
    __syncthreads();
    const int qq = l15 >> 2, pp = lane & 3;
#pragma unroll
    for (int hh = 0; hh < 4; ++hh) {
        const int h = kvh * 4 + hh; const float slope = __builtin_amdgcn_exp2f(-0.5f * (float)(h + 1)); const float sink = F.sinks[h];
        bf16_t* qp = H + (size_t)(b * SEQ + qb * 128 + 16 * qt + l15) * INW + C_Q + h * 64;
        const bf16x8 q0 = qf[hh][0], q1 = qf[hh][1];
        f32x4 st[9];
#pragma unroll
        for (int kt = 0; kt < 9; ++kt) { const LAS bf16_t* kp = Ks + (16 * (qt + kt) + l15) * KP + 8 * g;
            const bf16x8 k0 = *(const LAS bf16x8*)kp, k1 = *(const LAS bf16x8*)(kp + 32);
            f32x4 z = {0.f, 0.f, 0.f, 0.f}; z = MFMA16(k0, q0, z); st[kt] = MFMA16(k1, q1, z); }
        float mx = sink;
#pragma unroll
        for (int kt = 0; kt < 9; ++kt)
#pragma unroll
            for (int i = 0; i < 4; ++i) { const int diff = 128 + l15 - 16 * kt - 4 * g - i; const int j = 16 * (qt + kt) + 4 * g + i;
                const bool valid = (diff >= 0) && (diff <= 128) && (qb > 0 || j >= 128);
                const float s = valid ? (st[kt][i] * 0.125f - slope * (float)diff) : -1e30f; st[kt][i] = s; mx = fmaxf(mx, s); }
        mx = fmaxf(mx, __shfl_xor(mx, 16)); mx = fmaxf(mx, __shfl_xor(mx, 32));
        float sum = 0.f;
#pragma unroll
        for (int kt = 0; kt < 9; ++kt)
#pragma unroll
            for (int i = 0; i < 4; ++i) { const float p = __builtin_amdgcn_exp2f((st[kt][i] - mx) * LOG2E); st[kt][i] = p; sum += p; }
        sum += __shfl_xor(sum, 16); sum += __shfl_xor(sum, 32);
        sum += __builtin_amdgcn_exp2f((sink - mx) * LOG2E);
        const float inv = 1.0f / sum;
        f32x4 o[4];
#pragma unroll
        for (int c = 0; c < 4; ++c) o[c] = (f32x4){0.f, 0.f, 0.f, 0.f};
#pragma unroll
        for (int ks = 0; ks < 5; ++ks) {
            u32x4 pw; pw.x = cvt_pk_bf16(st[2 * ks][0] * inv, st[2 * ks][1] * inv); pw.y = cvt_pk_bf16(st[2 * ks][2] * inv, st[2 * ks][3] * inv);
            if (ks < 4) { pw.z = cvt_pk_bf16(st[2 * ks + 1][0] * inv, st[2 * ks + 1][1] * inv); pw.w = cvt_pk_bf16(st[2 * ks + 1][2] * inv, st[2 * ks + 1][3] * inv); } else { pw.z = 0u; pw.w = 0u; }
            const bf16x8 pf = __builtin_bit_cast(bf16x8, pw);
            const LAS bf16_t* vb = Vs + (16 * (qt + 2 * ks) + 4 * g + qq) * KP + 4 * pp;
#pragma unroll
            for (int c = 0; c < 4; ++c) { const s16x4 lo = tr_read(vb + 16 * c), hi = tr_read(vb + 16 * KP + 16 * c);
                const bf16x8 vf = {lo[0], lo[1], lo[2], lo[3], hi[0], hi[1], hi[2], hi[3]};
                o[c] = MFMA16(vf, pf, o[c]); }
        }
#pragma unroll
        for (int c = 0; c < 4; ++c) { u32x2 w; w.x = cvt_pk_bf16(o[c][0], o[c][1]); w.y = cvt_pk_bf16(o[c][2], o[c][3]); *(u32x2*)(qp + 16 * c + 4 * g) = w; }
    }
    __syncthreads();
}

constexpr int VNP = 136;
__device__ __forceinline__ void sgu_unit(const Ctx& F, LAS unsigned char* lds, bf16_t* H, const float* vss, const bf16_t* Wt, int b, int ch_, int gi) {
    const int tid_ = opaque_tid(), lane_ = tid_ & 63, wave_ = __builtin_amdgcn_readfirstlane(tid_ >> 6);
    LAS bf16_t* VN = (LAS bf16_t*)lds; LAS float* rs = (LAS float*)(lds + 128 * VNP * 2);
    const int tid = tid_, lane = lane_, l15 = lane & 15, g = lane >> 4, tt = wave_;
    const size_t rowbase = (size_t)b * SEQ + (size_t)ch_ * 128;
    f32x4 s4 = {0.f, 0.f, 0.f, 0.f};
    if (tid < 128) { const f32x4* sp = (const f32x4*)(vss + (rowbase + tid) * 16); s4 = (sp[0] + sp[1]) + (sp[2] + sp[3]); }
    const int cc = tid & 15; const f32x4 g0 = *(const f32x4*)(F.gs + gi * 128 + cc * 8), g1v = *(const f32x4*)(F.gs + gi * 128 + cc * 8 + 4);
    u32x4 vw[4];
#pragma unroll
    for (int i = 0; i < 4; ++i) vw[i] = *(const u32x4*)(H + (rowbase + (tid >> 4) + 32 * i) * INW + C_V + gi * 128 + cc * 8);
    const int nks = (tt >> 1) + 1; const int qq = l15 >> 2, pp = lane & 3;
    bf16x8 wf[4];
#pragma unroll
    for (int ks = 0; ks < 4; ++ks) wf[ks] = (ks < nks) ? *(const bf16x8*)(Wt + ((size_t)gi * 128 + 16 * tt + l15) * 128 + 32 * ks + 8 * g) : (bf16x8){0, 0, 0, 0, 0, 0, 0, 0};
    const float bias = F.sgu_b[gi * 128 + 16 * tt + l15];
    bf16_t* up = H + (rowbase + 16 * tt + l15) * INW + C_U + gi * 128 + 4 * g;
    u32x2 uw[8];
#pragma unroll
    for (int c = 0; c < 8; ++c) uw[c] = *(const u32x2*)(up + 16 * c);
    if (tid < 128) rs[tid] = 1.0f / sqrtf(((s4[0] + s4[1]) + (s4[2] + s4[3])) * (1.0f / D) + EPS);
    __syncthreads();
#pragma unroll
    for (int i = 0; i < 4; ++i) { const int s = (tid >> 4) + 32 * i; const float r = rs[s]; const u32x4 w = vw[i];
        u32x4 o; o.x = cvt_pk_bf16(bflo(w.x) * r * g0[0], bfhi(w.x) * r * g0[1]); o.y = cvt_pk_bf16(bflo(w.y) * r * g0[2], bfhi(w.y) * r * g0[3]);
        o.z = cvt_pk_bf16(bflo(w.z) * r * g1v[0], bfhi(w.z) * r * g1v[1]); o.w = cvt_pk_bf16(bflo(w.w) * r * g1v[2], bfhi(w.w) * r * g1v[3]);
        *(LAS u32x4*)(VN + s * VNP + cc * 8) = o; }
    __syncthreads();
#pragma unroll
    for (int c = 0; c < 8; ++c) { f32x4 acc = {0.f, 0.f, 0.f, 0.f};
#pragma unroll
        for (int ks = 0; ks < 4; ++ks) if (ks < nks) { const LAS bf16_t* vb = VN + (32 * ks + 8 * g + qq) * VNP + 16 * c + 4 * pp;
            const s16x4 lo = tr_read(vb), hi = tr_read(vb + 4 * VNP);
            const bf16x8 vf = {lo[0], lo[1], lo[2], lo[3], hi[0], hi[1], hi[2], hi[3]};
            acc = MFMA16(vf, wf[ks], acc); }
        u32x2 w; w.x = cvt_pk_bf16(bflo(uw[c].x) * (acc[0] + bias), bfhi(uw[c].x) * (acc[1] + bias)); w.y = cvt_pk_bf16(bflo(uw[c].y) * (acc[2] + bias), bfhi(uw[c].y) * (acc[3] + bias));
        *(u32x2*)(up + 16 * c) = w; }
    __syncthreads();
}

__device__ __forceinline__ void sample_wave(const Ctx& F, int b, int h, int lane) {
    const float* Hs = (const float*)(F.ws + WS_HS) + (size_t)b * INW; bf16_t* ABs = (bf16_t*)(F.ws + WS_ABS) + (size_t)b * 2048;
    { float ss = 0.f;
#pragma unroll
      for (int j = 0; j < 4; ++j) { const f32x4 v = ((const f32x4*)(Hs + C_V) + lane)[64 * j]; ss += (v.x * v.x + v.y * v.y) + (v.z * v.z + v.w * v.w); }
      const float r = 1.0f / sqrtf(wave_sum(ss) * (1.0f / D) + EPS); const int d = h * 64 + lane, gi = d >> 7;
      const float vn = Hs[C_V + d] * r * F.gs[d];
      F.out[O_SGV + (size_t)b * D + d] = vn;
      const float a = Hs[C_U + d] * (F.sgu_w[gi * 16384] * vn + F.sgu_b[gi * 128]);
      ABs[d] = (bf16_t)(cvt_pk_bf16(a, 0.f) & 0xffffu); }
    const int gg = lane >> 4, c16 = lane & 15, kvh = h >> 2; const float slope = __builtin_amdgcn_exp2f(-0.5f * (float)(h + 1)); const float sink = F.sinks[h];
    const f32x4 q = *(const f32x4*)(Hs + C_Q + h * 64 + 4 * c16);
    const float* kb = F.ck + ((size_t)(b * 128 + gg) * 4 + kvh) * 64 + 4 * c16; const float* vb = F.cv + ((size_t)(b * 128 + gg) * 4 + kvh) * 64 + 4 * c16;
    float s[32];
#pragma unroll
    for (int i0 = 0; i0 < 32; i0 += 8) { f32x4 kk[8];
#pragma unroll
        for (int i = 0; i < 8; ++i) kk[i] = *(const f32x4*)(kb + (size_t)(i0 + i) * 1024);
#pragma unroll
        for (int i = 0; i < 8; ++i) { float d = (kk[i].x * q.x + kk[i].y * q.y) + (kk[i].z * q.z + kk[i].w * q.w);
            d += __shfl_xor(d, 1); d += __shfl_xor(d, 2); d += __shfl_xor(d, 4); d += __shfl_xor(d, 8);
            s[i0 + i] = d * 0.125f - slope * (float)(128 - (4 * (i0 + i) + gg)); } }
    float sn; { const f32x4 kn = *(const f32x4*)(Hs + C_K + kvh * 64 + 4 * c16); float d = (kn.x * q.x + kn.y * q.y) + (kn.z * q.z + kn.w * q.w);
        d += __shfl_xor(d, 1); d += __shfl_xor(d, 2); d += __shfl_xor(d, 4); d += __shfl_xor(d, 8); sn = d * 0.125f; }
    float mx = fmaxf(sink, sn);
#pragma unroll
    for (int i = 0; i < 32; ++i) mx = fmaxf(mx, s[i]);
    mx = fmaxf(mx, __shfl_xor(mx, 16)); mx = fmaxf(mx, __shfl_xor(mx, 32));
    float sum = 0.f;
#pragma unroll
    for (int i = 0; i < 32; ++i) { s[i] = __builtin_amdgcn_exp2f((s[i] - mx) * LOG2E); sum += s[i]; }
    sum += __shfl_xor(sum, 16); sum += __shfl_xor(sum, 32);
    const float pn = __builtin_amdgcn_exp2f((sn - mx) * LOG2E);
    sum += pn + __builtin_amdgcn_exp2f((sink - mx) * LOG2E);
    f32x4 o = {0.f, 0.f, 0.f, 0.f};
#pragma unroll
    for (int i0 = 0; i0 < 32; i0 += 8) { f32x4 vv[8];
#pragma unroll
        for (int i = 0; i < 8; ++i) vv[i] = *(const f32x4*)(vb + (size_t)(i0 + i) * 1024);
#pragma unroll
        for (int i = 0; i < 8; ++i) o += vv[i] * s[i0 + i]; }
#pragma unroll
    for (int e = 0; e < 4; ++e) { o[e] += __shfl_xor(o[e], 16); o[e] += __shfl_xor(o[e], 32); }
    const f32x4 vn4 = *(const f32x4*)(Hs + C_VA + kvh * 64 + 4 * c16);
    o = (o + vn4 * pn) * (1.0f / sum);
    if (gg == 0) { u32x2 w; w.x = cvt_pk_bf16(o[0], o[1]); w.y = cvt_pk_bf16(o[2], o[3]); *(u32x2*)(ABs + 1024 + h * 64 + 4 * c16) = w; }
}

#define XB_TMO      128
#define XB_XCNT(j)  (256  + 64 * (j))
#define XB_XSUB(j)  (1280 + 64 * (j))
#define XB_XGEN(j)  (2304 + 64 * (j))
#define XB_TOP      3328
#define XB_TOPGEN   3392
#define XCD_BAR_WORDS 3456
#define XB_SPIN_CAP (1u << 18)
__device__ __forceinline__ unsigned xb_ld(unsigned* p)              { return __hip_atomic_load(p, __ATOMIC_RELAXED, __HIP_MEMORY_SCOPE_AGENT); }
__device__ __forceinline__ unsigned xb_add(unsigned* p, unsigned v) { return __hip_atomic_fetch_add(p, v, __ATOMIC_RELAXED, __HIP_MEMORY_SCOPE_AGENT); }
__device__ __forceinline__ unsigned xb_xcc_id() { return (unsigned)__builtin_amdgcn_s_getreg((3 << 11) | 20) & 0xFu; }
#define XB_SPIN(cond, bar) do { unsigned _sp = 0; while (cond) { __builtin_amdgcn_s_sleep(1); \
    if ((++_sp & 255u) == 0u) { if (xb_ld(&(bar)[XB_TMO])) break; if (_sp > XB_SPIN_CAP) { atomicAdd(&(bar)[XB_TMO], 1u); break; } } } } while (0)
struct XcdBarrier { unsigned* bar; unsigned x; volatile LAS unsigned* st; };
__device__ __forceinline__ XcdBarrier xcd_barrier_post(unsigned* bar, volatile LAS unsigned* st) {
    XcdBarrier b; b.bar = bar; b.x = xb_xcc_id(); b.st = st;
    if (threadIdx.x == 0) (void)xb_add(&bar[XB_XCNT(b.x)], 1u);
    return b;
}
__device__ __forceinline__ void xcd_barrier_complete(unsigned* bar, unsigned x, unsigned& nloc, unsigned& nx) {
    const unsigned G = gridDim.x * gridDim.y * gridDim.z;
    unsigned sum, cnt, mine, sp = 0u;
    for (;;) {
        sum = 0u; cnt = 0u; mine = 0u;
#pragma unroll
        for (unsigned j = 0; j < 16; ++j) { const unsigned c = xb_ld(&bar[XB_XCNT(j)]); sum += c; cnt += (c > 0u) ? 1u : 0u; mine = (j == x) ? c : mine; }
        if (sum == G) break;
        __builtin_amdgcn_s_sleep(1);
        if ((++sp & 255u) == 0u) { if (xb_ld(&bar[XB_TMO])) break; if (sp > XB_SPIN_CAP) { atomicAdd(&bar[XB_TMO], 1u); break; } }
    }
    nloc = mine > 0u ? mine : 1u; nx = cnt > 0u ? cnt : 1u;
}
__device__ __forceinline__ void xcd_barrier(const XcdBarrier& b) {
    asm volatile("s_waitcnt vmcnt(0)" ::: "memory");
    __syncthreads();
    if (threadIdx.x == 0) {
        unsigned* bar = b.bar;
        __builtin_amdgcn_s_waitcnt(0);
        unsigned nloc = b.st[0], nx = b.st[1];
        if (nloc == 0u) { xcd_barrier_complete(bar, b.x, nloc, nx); b.st[0] = nloc; b.st[1] = nx; }
        const unsigned old = xb_add(&bar[XB_XSUB(b.x)], 1u);
        const unsigned gen = old / nloc;
        if (old + 1u == (gen + 1u) * nloc) {
            __builtin_amdgcn_fence(__ATOMIC_RELEASE, "agent");
            asm volatile("s_waitcnt vmcnt(0)" ::: "memory");
            const unsigned og = xb_add(&bar[XB_TOP], 1u);
            const unsigned tg = og / nx;
            if (og + 1u == (tg + 1u) * nx) xb_add(&bar[XB_TOPGEN], 1u);
            else XB_SPIN(xb_ld(&bar[XB_TOPGEN]) == tg, bar);
            __builtin_amdgcn_fence(__ATOMIC_ACQUIRE, "agent");
            xb_add(&bar[XB_XGEN(b.x)], 1u);
            asm volatile("s_waitcnt vmcnt(0)" ::: "memory");
        } else {
            XB_SPIN(xb_ld(&bar[XB_XGEN(b.x)]) == gen, bar);
            __builtin_amdgcn_fence(__ATOMIC_ACQUIRE, "agent");
            asm volatile("s_waitcnt vmcnt(0)" ::: "memory");
        }
    }
    __syncthreads();
}

#define PHASE_IDS const int tid_ = opaque_tid(), lane = tid_ & 63, wave = __builtin_amdgcn_readfirstlane(tid_ >> 6), l15 = lane & 15, g4 = lane >> 4; (void)l15; (void)g4; (void)wave;
__global__ void __launch_bounds__(512, 2) fwd_megakernel(Args args) {
    extern __shared__ __attribute__((aligned(16))) unsigned char lds_raw[];
    LAS unsigned char* lds = (LAS unsigned char*)lds_raw;
    cg::grid_group grid = cg::this_grid();
    Ctx F;
    F.xp = args.in[0]; F.xs = args.in[1]; F.ck = args.in[2]; F.cv = args.in[3]; F.g1 = args.in[4]; F.w_in = args.in[5]; F.gs = args.in[6]; F.sgu_w = args.in[7];
    F.sgu_b = args.in[8]; F.sinks = args.in[9]; F.w_oa = args.in[10]; F.w_ob = args.in[11]; F.w_out = args.in[12]; F.g2 = args.in[13]; F.w_up = args.in[14];
    F.w_down = args.in[15]; F.gf = args.in[16]; F.out = args.out; F.ws = args.ws;
    F.G = gridDim.x; F.bid = blockIdx.x;
    unsigned char* ws = args.ws;
    float* vss = (float*)(ws + WS_VSS); float* x1ss = (float*)(ws + WS_X1SS);
    bf16_t* H = (bf16_t*)(ws + WS_H); bf16_t* XN = (bf16_t*)(ws + WS_XN); bf16_t* T1 = (bf16_t*)(ws + WS_T1); bf16_t* X1B = (bf16_t*)(ws + WS_X1B); bf16_t* Fb = (bf16_t*)(ws + WS_F);
    bf16_t* WinT = (bf16_t*)(ws + WS_WIN); bf16_t* WoabT = (bf16_t*)(ws + WS_WOAB); bf16_t* WoutT = (bf16_t*)(ws + WS_WOUT); bf16_t* WupT = (bf16_t*)(ws + WS_WUP); bf16_t* WdownT = (bf16_t*)(ws + WS_WDOWN);
    bf16_t* XNs = (bf16_t*)(ws + WS_XNS); float* Hs = (float*)(ws + WS_HS); bf16_t* ABs = (bf16_t*)(ws + WS_ABS); bf16_t* Hgs = (bf16_t*)(ws + WS_HGS);
    float* X1s = (float*)(ws + WS_X1S); bf16_t* X1Bs = (bf16_t*)(ws + WS_X1BS); bf16_t* Fs = (bf16_t*)(ws + WS_FS); float* Ds = (float*)(ws + WS_DS);
    const bf16_t* Wt = (const bf16_t*)(ws + WS_WTRIL);
    float* y = F.out + O_YP;

    unsigned* barw = (unsigned*)(ws + WS_BAR);
    if (threadIdx.x < 4) ((LAS unsigned*)(lds + (LDS_BYTES - 256)))[threadIdx.x] = 0u;
    if (blockIdx.x == 0) for (int i = threadIdx.x; i < XCD_BAR_WORDS; i += 512) __hip_atomic_store(barw + i, 0u, __ATOMIC_RELAXED, __HIP_MEMORY_SCOPE_AGENT);
    __syncthreads();
    p0_prologue(F, lds);
    grid.sync();
    const XcdBarrier xb = xcd_barrier_post(barw, (volatile LAS unsigned*)(lds + (LDS_BYTES - 256)));

    { PHASE_IDS
    for (int it = F.bid; it < INW / 32; it += F.G) { const int n0 = it * 32; f32x4 acc[2];
        skinny_lds<2>(lds, XNs, D, WinT + (size_t)n0 * D, D, acc);
#pragma unroll
        for (int t = 0; t < 2; ++t) { const int row = 16 * wave + l15, col = n0 + 16 * t + 4 * g4; f32x4 o;
#pragma unroll
            for (int i = 0; i < 4; ++i) o[i] = act_in(acc[t][i], col);
            *(f32x4*)(Hs + (size_t)row * INW + col) = o; } } }
    { pg8::Gemm g{XN, WinT, D, D, 0, 0}; pg8::StaticOrder S; S.init(MP, INW, F.G, F.bid, 1); pg8::EpiIn E{H, vss};
      pg8::gemm_phase<pg8::EpiIn, pg8::StaticOrder, true, true>(lds, g, S, E); }
    xcd_barrier(xb);

    { PHASE_IDS const int gt = F.bid * 512 + tid_, GT = F.G * 512;
      for (int wi = F.bid * 8 + wave; wi < NS * 16; wi += F.G * 8) sample_wave(F, wi >> 4, wi & 15, lane);
      for (int idx = gt; idx < 128 * 64; idx += GT) { const int b = idx >> 6, c4 = idx & 63;
          *(f32x4*)(F.out + O_KWS + ((size_t)(b * 128 + 127) * 256 + c4 * 4)) = *(const f32x4*)(Hs + (size_t)b * INW + C_K + c4 * 4);
          *(f32x4*)(F.out + O_VWS + ((size_t)(b * 128 + 127) * 256 + c4 * 4)) = *(const f32x4*)(Hs + (size_t)b * INW + C_VA + c4 * 4); }
      for (int idx = gt; idx < 4 * 128 * 64; idx += GT) { const int b = idx >> 13, w = (idx >> 6) & 127, c8 = idx & 63;
          const u32x4 wv = *(const u32x4*)(H + (size_t)(b * SEQ + SEQ - 128 + w) * INW + C_K + c8 * 8);
          float* op = F.out + (c8 < 32 ? O_KWP : O_VWP) + (size_t)(b * 128 + w) * 256 + (c8 & 31) * 8;
          *(f32x4*)op = (f32x4){bflo(wv.x), bfhi(wv.x), bflo(wv.y), bfhi(wv.y)}; *(f32x4*)(op + 4) = (f32x4){bflo(wv.z), bfhi(wv.z), bflo(wv.w), bfhi(wv.w)}; }
    }
    for (int it = F.bid; it < 512 + 1024; it += F.G) {
        if (it < 512) { const int qb = it & 31, kvh = (it >> 5) & 3, b = it >> 7; attn_unit(F, lds, H, b, kvh, qb); }
        else { const int r = it - 512; const int gi = r & 7, ch = (r >> 3) & 31, b = r >> 8; sgu_unit(F, lds, H, vss, Wt, b, ch, gi); }
    }
    xcd_barrier(xb);

    { PHASE_IDS
    for (int it = F.bid; it < D / 16; it += F.G) { const int n0 = it * 16;
        f32x4 a1[1], b1[1]; skinny_lds<1>(lds, ABs, 2048, WoabT + (size_t)n0 * D, D, a1); skinny_lds<1>(lds, ABs + 1024, 2048, WoabT + (size_t)(1024 + n0) * D, D, b1);
        const f32x4 accA = a1[0], accB = b1[0];
        const int row = 16 * wave + l15, col = n0 + 4 * g4;
        const f32x4 ga = *(const f32x4*)(Hs + (size_t)row * INW + C_GA + col), gb = *(const f32x4*)(Hs + (size_t)row * INW + C_GB + col);
        const f32x4 hv = ga * accA + gb * accB; u32x2 w; w.x = cvt_pk_bf16(hv[0], hv[1]); w.y = cvt_pk_bf16(hv[2], hv[3]);
        *(u32x2*)(Hgs + (size_t)row * D + col) = w; } }
    __syncthreads();
    { pg8::Gemm g{H + C_U, WoabT, INW, D, (size_t)(C_Q - C_U) * 2, 4}; pg8::StaticOrder S; S.init(MP, D, F.G, F.bid, 2); pg8::EpiOab E{H, T1};
      pg8::gemm_phase<pg8::EpiOab, pg8::StaticOrder, true, true>(lds, g, S, E); }
    xcd_barrier(xb);

    { PHASE_IDS
    for (int it = F.bid; it < D / 16; it += F.G) { const int n0 = it * 16;
        f32x4 a1[1]; skinny_lds<1>(lds, Hgs, D, WoutT + (size_t)n0 * D, D, a1); const f32x4 acc = a1[0];
        const int row = 16 * wave + l15, col = n0 + 4 * g4;
        const f32x4 v = acc + *(const f32x4*)(F.xs + (size_t)row * D + col);
        *(f32x4*)(X1s + (size_t)row * D + col) = v; u32x2 w; w.x = cvt_pk_bf16(v[0], v[1]); w.y = cvt_pk_bf16(v[2], v[3]); *(u32x2*)(X1Bs + (size_t)row * D + col) = w; } }
    __syncthreads();
    { pg8::Gemm g{T1, WoutT, D, D, 0, 0}; pg8::StaticOrder S; S.init(MP, D, F.G, F.bid, 1); pg8::EpiOut E{F.xp, y, X1B, x1ss};
      pg8::gemm_phase<pg8::EpiOut, pg8::StaticOrder, true, true>(lds, g, S, E); }
    xcd_barrier(xb);

    { const int t_ = opaque_tid(); for (int row = F.bid * 512 + t_; row < MP; row += F.G * 512) { const f32x4* sp = (const f32x4*)(x1ss + (size_t)row * 16); const f32x4 s4 = (sp[0] + sp[1]) + (sp[2] + sp[3]);
        ((float*)(ws + WS_VSS))[row] = ((s4[0] + s4[1]) + (s4[2] + s4[3])) * (1.0f / D) + EPS; } }
    { PHASE_IDS
    for (int it = F.bid; it < FF / 16; it += F.G) { const int n0 = it * 16;
        f32x4 a1[1]; skinny_lds<1>(lds, X1Bs, D, WupT + (size_t)n0 * D, D, a1); const f32x4 acc = a1[0];
        const int row = 16 * wave + l15, col = n0 + 4 * g4; f32x4 v;
#pragma unroll
        for (int i = 0; i < 4; ++i) { const float a = fmaxf(acc[i], 0.f); v[i] = a * a; }
        u32x2 w; w.x = cvt_pk_bf16(v[0], v[1]); w.y = cvt_pk_bf16(v[2], v[3]); *(u32x2*)(Fs + (size_t)row * FF + col) = w; } }
    __syncthreads();
    { pg8::Gemm g{X1B, WupT, D, D, 0, 0}; pg8::StaticOrder S; S.init(MP, FF, F.G, F.bid, 1); pg8::EpiUp E{Fb};
      pg8::gemm_phase<pg8::EpiUp, pg8::StaticOrder, true, true>(lds, g, S, E); }
    xcd_barrier(xb);

    { PHASE_IDS
    for (int it = F.bid; it < 256; it += F.G) { const int n0 = (it & 63) * 16, ks = it >> 6;
        f32x4 a1[1]; skinny_lds<1>(lds, Fs + ks * 1024, FF, WdownT + (size_t)n0 * FF + ks * 1024, FF, a1); const f32x4 acc = a1[0];
        const int row = 16 * wave + l15, col = n0 + 4 * g4;
        *(f32x4*)(Ds + ((size_t)ks * NS + row) * D + col) = acc; } }
    __syncthreads();
    { pg8::Gemm g{Fb, WdownT, FF, FF, 0, 0}; pg8::StaticOrder S; S.init(MP, D, F.G, F.bid, 1); pg8::EpiDown E{y, (const float*)(ws + WS_VSS)};
      pg8::gemm_phase<pg8::EpiDown, pg8::StaticOrder, true, true>(lds, g, S, E); }
    xcd_barrier(xb);

    { PHASE_IDS const int gw = F.bid * 8 + wave, NGW = F.G * 8;
      for (int m = gw; m < MP + NS; m += NGW) {
          f32x4 v[4]; const f32x4* gr = (const f32x4*)F.gf + lane; float* orow;
          if (m < MP) { orow = y + (size_t)m * D; const f32x4* xr = (const f32x4*)orow + lane;
#pragma unroll
              for (int j = 0; j < 4; ++j) v[j] = xr[64 * j];
          } else { const int r = m - MP; orow = F.out + O_YS + (size_t)r * D; const f32x4* xr = (const f32x4*)(X1s + (size_t)r * D) + lane; float s1 = 0.f;
#pragma unroll
              for (int j = 0; j < 4; ++j) { v[j] = xr[64 * j]; s1 += (v[j].x * v[j].x + v[j].y * v[j].y) + (v[j].z * v[j].z + v[j].w * v[j].w); }
              const float r2 = 1.0f / (wave_sum(s1) * (1.0f / D) + EPS);
#pragma unroll
              for (int j = 0; j < 4; ++j) { f32x4 d = {0.f, 0.f, 0.f, 0.f};
#pragma unroll
                  for (int ks = 0; ks < 4; ++ks) d += ((const f32x4*)(Ds + ((size_t)ks * NS + r) * D) + lane)[64 * j];
                  v[j] += d * r2; }
          }
          float s = 0.f;
#pragma unroll
          for (int j = 0; j < 4; ++j) s += (v[j].x * v[j].x + v[j].y * v[j].y) + (v[j].z * v[j].z + v[j].w * v[j].w);
          const float rr = 1.0f / sqrtf(wave_sum(s) * (1.0f / D) + EPS);
#pragma unroll
          for (int j = 0; j < 4; ++j) ((f32x4*)orow + lane)[64 * j] = v[j] * rr * gr[64 * j];
      }
    }
}

extern "C" void kernel_launch(void* const* d_in, const int* in_sizes, int n_in, void* d_out, int out_size, void* d_ws, size_t ws_size, hipStream_t stream) {
    static int grid = 0;
    if (grid == 0) {
        if (n_in != 17 || in_sizes[0] != MP * D || (size_t)out_size != O_END || ws_size < WS_END) {
            fprintf(stderr, "kernel_launch: unexpected shapes: n_in %d in0 %d out %d ws %zu\n", n_in, n_in > 0 ? in_sizes[0] : -1, out_size, ws_size); grid = -1; return; }
        int dev = 0, cus = 0, per_cu = 0;
        hipGetDevice(&dev); hipDeviceGetAttribute(&cus, hipDeviceAttributeMultiprocessorCount, dev);
        if (hipFuncSetAttribute((const void*)fwd_megakernel, hipFuncAttributeMaxDynamicSharedMemorySize, LDS_BYTES) != hipSuccess) { fprintf(stderr, "kernel_launch: hipFuncSetAttribute failed\n"); grid = -1; return; }
        if (hipOccupancyMaxActiveBlocksPerMultiprocessor(&per_cu, (const void*)fwd_megakernel, 512, LDS_BYTES) != hipSuccess || per_cu < 1) { fprintf(stderr, "kernel_launch: occupancy query gave %d\n", per_cu); per_cu = 1; }
        (void)hipGetLastError();
        grid = cus * 1;
        if (grid > 256) grid = 256;
    }
    if (grid < 0) return;
    Args a{};
    for (int i = 0; i < 17; ++i) a.in[i] = (const float*)d_in[i];
    a.out = (float*)d_out; a.ws = (unsigned char*)d_ws;
    void* kargs[] = {&a};
    hipError_t e = hipLaunchCooperativeKernel((const void*)fwd_megakernel, dim3(grid), dim3(512), kargs, LDS_BYTES, stream);
    if (e != hipSuccess) fprintf(stderr, "kernel_launch: cooperative launch failed: %s (grid %d)\n", hipGetErrorString(e), grid);
}
```
